# Optimizing an MI355X kernel written in HIP

```python
import jax, jax.numpy as jnp
from jax import lax
import numpy as np

D_MODEL = 1024
BATCH = 4
SEQ = 4096
DEPTH = 1

N_META = 16
LRU_WIDTH = 1024
LRU_HEADS = 8
LRU_BLOCK = LRU_WIDTH // LRU_HEADS
CONV_WIDTH = 4
LRU_C = 8.0
RET_HEADS = 8
RET_QK_DIM = 64
RET_V_DIM = 128
RET_QK_WIDTH = RET_HEADS * RET_QK_DIM
RET_WIDTH = RET_HEADS * RET_V_DIM
CHUNK = 128
ROPE_BASE = 10000.0
MIX_WIDTH = LRU_WIDTH + RET_WIDTH
SPLIT_SIZES = (LRU_WIDTH, LRU_WIDTH, RET_QK_WIDTH, RET_QK_WIDTH, RET_WIDTH, RET_WIDTH)
IN_WIDTH = sum(SPLIT_SIZES)
EPS = 1e-6

kernel_name = 'hymba_style_rglru_retention_hybrid'


def _rmsnorm(x, g):
    xf = x.astype(jnp.float32)
    y = xf * lax.rsqrt(jnp.mean(xf * xf, axis=-1, keepdims=True) + EPS)
    return (y * g.astype(jnp.float32)).astype(x.dtype)


def _causal_conv(x, w, b):
    T = x.shape[1]
    xp = jnp.pad(x, ((0, 0), (CONV_WIDTH - 1, 0), (0, 0)))
    y = b
    for k in range(CONV_WIDTH):
        y = y + xp[:, k:k + T] * w[k]
    return y


def _block_diag(x, w, b):
    B, T, _ = x.shape
    xh = x.reshape(B, T, LRU_HEADS, LRU_BLOCK)
    return jnp.einsum('bthi,hij->bthj', xh, w).reshape(B, T, LRU_WIDTH) + b


def _rg_lru(x, w_rg, b_rg, w_ig, b_ig, lam):
    r = jax.nn.sigmoid(_block_diag(x, w_rg, b_rg).astype(jnp.float32))
    i = jax.nn.sigmoid(_block_diag(x, w_ig, b_ig).astype(jnp.float32))
    log_a = -LRU_C * r * jax.nn.softplus(-lam.astype(jnp.float32))
    a = jnp.exp(log_a)
    beta = jnp.sqrt(-jnp.expm1(2.0 * log_a))
    u = beta * i * x.astype(jnp.float32)

    def combine(lhs, rhs):
        a1, b1 = lhs
        a2, b2 = rhs
        return a1 * a2, a2 * b1 + b2

    _, h = lax.associative_scan(combine, (a, u), axis=1)
    return h.astype(x.dtype)


def _rotary(t, pos):
    half = RET_QK_DIM // 2
    inv = ROPE_BASE ** (-jnp.arange(half, dtype=jnp.float32) / half)
    ang = pos.astype(jnp.float32)[:, None] * inv[None, :]
    cos = jnp.cos(ang)[None, :, None, :]
    sin = jnp.sin(ang)[None, :, None, :]
    t1, t2 = t[..., :half], t[..., half:]
    return jnp.concatenate([t1 * cos - t2 * sin, t1 * sin + t2 * cos], axis=-1)


def _retention(q, k, v):
    B, T, H, _ = q.shape
    pad = (-N_META) % CHUNK
    widths = ((0, 0), (pad, 0), (0, 0), (0, 0))
    q, k, v = jnp.pad(q, widths), jnp.pad(k, widths), jnp.pad(v, widths)
    n = (T + pad) // CHUNK
    q = q.reshape(B, n, CHUNK, H, RET_QK_DIM)
    k = k.reshape(B, n, CHUNK, H, RET_QK_DIM)
    v = v.reshape(B, n, CHUNK, H, RET_V_DIM)
    log_g = jnp.log1p(-jnp.exp2(-5.0 - jnp.arange(RET_HEADS, dtype=jnp.float32)))
    idx = jnp.arange(CHUNK, dtype=jnp.float32)
    diff = idx[:, None] - idx[None, :]
    dmask = jnp.where(diff[None] >= 0.0,
                      jnp.exp(jnp.maximum(diff, 0.0)[None] * log_g[:, None, None]), 0.0)
    s = jnp.einsum('bnchd,bnmhd->bnhcm', q, k) * dmask
    inner = jnp.einsum('bnhcm,bnmhe->bnche', s, v)
    k_dec = k * jnp.exp((CHUNK - 1.0 - idx)[:, None] * log_g[None, :])[:, :, None]
    kv = jnp.einsum('bnchd,bnche->bnhde', k_dec, v)
    g_chunk = jnp.exp(CHUNK * log_g)[None, :, None, None]

    def step(state, kv_n):
        return g_chunk * state + kv_n, state

    init = jnp.zeros((B, H, RET_QK_DIM, RET_V_DIM), jnp.float32)
    _, r_prev = lax.scan(step, init, jnp.moveaxis(kv, 1, 0))
    r_prev = jnp.moveaxis(r_prev, 0, 1)
    q_dec = q * jnp.exp((idx + 1.0)[:, None] * log_g[None, :])[:, :, None]
    cross = jnp.einsum('bnchd,bnhde->bnche', q_dec, r_prev)
    o = (inner + cross).reshape(B, n * CHUNK, H, RET_V_DIM)
    return o[:, pad:]


def _head_norm(o, g):
    mu = jnp.mean(o, axis=-1, keepdims=True)
    oc = o - mu
    var = jnp.mean(oc * oc, axis=-1, keepdims=True)
    return oc * lax.rsqrt(var + EPS) * g.astype(jnp.float32).reshape(RET_HEADS, RET_V_DIM)


def setup_inputs(seed: int = 0) -> dict:
    key = jax.random.key(seed)
    ks = jax.random.split(key, 16)
    f32 = jnp.float32
    x = jax.random.normal(ks[0], (BATCH, SEQ, D_MODEL), f32)
    meta_tokens = jax.random.normal(ks[1], (N_META, D_MODEL), f32)
    norm_gain = 1.0 + 0.01 * jax.random.normal(ks[2], (DEPTH, D_MODEL), f32)
    w_in = jax.random.normal(ks[3], (DEPTH, D_MODEL, IN_WIDTH), f32) * D_MODEL ** -0.5
    conv_w = jax.random.normal(ks[4], (DEPTH, CONV_WIDTH, LRU_WIDTH), f32) * CONV_WIDTH ** -0.5
    conv_b = 0.01 * jax.random.normal(ks[5], (DEPTH, LRU_WIDTH), f32)
    w_rg = jax.random.normal(ks[6], (DEPTH, LRU_HEADS, LRU_BLOCK, LRU_BLOCK), f32) * LRU_BLOCK ** -0.5
    b_rg = 0.01 * jax.random.normal(ks[7], (DEPTH, LRU_WIDTH), f32)
    w_ig = jax.random.normal(ks[8], (DEPTH, LRU_HEADS, LRU_BLOCK, LRU_BLOCK), f32) * LRU_BLOCK ** -0.5
    b_ig = 0.01 * jax.random.normal(ks[9], (DEPTH, LRU_WIDTH), f32)
    ac = jax.random.uniform(ks[10], (DEPTH, LRU_WIDTH), f32, minval=0.9, maxval=0.999)
    a = ac ** (1.0 / LRU_C)
    lru_lambda = jnp.log(a) - jnp.log1p(-a)
    ret_norm_gain = 1.0 + 0.01 * jax.random.normal(ks[11], (DEPTH, RET_WIDTH), f32)
    w_out = jax.random.normal(ks[12], (DEPTH, MIX_WIDTH, D_MODEL), f32) * MIX_WIDTH ** -0.5
    final_norm_gain = 1.0 + 0.01 * jax.random.normal(ks[13], (D_MODEL,), f32)
    return {'x': x, 'meta_tokens': meta_tokens, 'norm_gain': norm_gain, 'w_in': w_in,
            'conv_w': conv_w, 'conv_b': conv_b, 'w_rg': w_rg, 'b_rg': b_rg,
            'w_ig': w_ig, 'b_ig': b_ig, 'lru_lambda': lru_lambda,
            'ret_norm_gain': ret_norm_gain, 'w_out': w_out, 'final_norm_gain': final_norm_gain}


def reference(x, meta_tokens, norm_gain, w_in, conv_w, conv_b, w_rg, b_rg, w_ig, b_ig,
              lru_lambda, ret_norm_gain, w_out, final_norm_gain):
    B = x.shape[0]
    meta = jnp.broadcast_to(meta_tokens.astype(x.dtype)[None], (B, N_META, D_MODEL))
    h = jnp.concatenate([meta, x], axis=1)
    T = h.shape[1]
    pos = jnp.arange(T)
    split_idx = np.cumsum(SPLIT_SIZES)[:-1].tolist()
    for l in range(DEPTH):
        u = _rmsnorm(h, norm_gain[l])
        proj = jnp.einsum('btd,de->bte', u, w_in[l])
        lru_x, lru_gate, q, k, v, ret_gate = jnp.split(proj, split_idx, axis=-1)
        xc = _causal_conv(lru_x, conv_w[l], conv_b[l])
        y_lru = _rg_lru(xc, w_rg[l], b_rg[l], w_ig[l], b_ig[l], lru_lambda[l]) * jax.nn.silu(lru_gate)
        qh = _rotary(q.reshape(B, T, RET_HEADS, RET_QK_DIM).astype(jnp.float32), pos)
        kh = _rotary(k.reshape(B, T, RET_HEADS, RET_QK_DIM).astype(jnp.float32), pos) * RET_QK_DIM ** -0.5
        vh = v.reshape(B, T, RET_HEADS, RET_V_DIM).astype(jnp.float32)
        o = _head_norm(_retention(qh, kh, vh), ret_norm_gain[l])
        y_ret = o.reshape(B, T, RET_WIDTH).astype(x.dtype) * jax.nn.silu(ret_gate)
        y = jnp.concatenate([y_lru, y_ret], axis=-1)
        h = h + jnp.einsum('bte,ed->btd', y, w_out[l])
    return _rmsnorm(h, final_norm_gain)[:, N_META:]
```

```cpp
#include <hip/hip_runtime.h>
#include <hip/hip_cooperative_groups.h>
#include <cstdio>
#include <cstdint>
namespace cg = cooperative_groups;
#define DI __device__ __forceinline__

namespace pg8 {
#define PG8_LAS __attribute__((address_space(3)))
typedef unsigned short bf16_t;
typedef short bf16x8 __attribute__((ext_vector_type(8)));
typedef float f32x4 __attribute__((ext_vector_type(4)));
typedef unsigned u32x4 __attribute__((ext_vector_type(4)));
constexpr int BM = 256, BK = 64, HALF = 128, HTB = HALF * BK * 2  , STAGE_BYTES = 8 * HTB, NXCD = 8, WGM = 8;

__host__ __device__ __forceinline__ int lds_byte(int r, int c) { const int st = (r >> 4) * 2 + (c >> 5), rr = r & 15, cc = c & 31, ob = rr * 64 + cc * 2; return st * 1024 + (ob ^ (((ob >> 9) & 1) << 5)); }
__host__ __device__ __forceinline__ void stage_rc(int b, int& R, int& C) { const int st = b / 1024, sb = b % 1024, swz = sb ^ (((sb >> 9) & 1) << 5); R = (st >> 1) * 16 + swz / 64; C = (st & 1) * 32 + (swz % 64) / 2; }
__host__ __device__ __forceinline__ int perm32(int rho) { const int n = rho >> 4, i = rho & 15; return 8 * (i >> 2) + 4 * n + (i & 3); }

struct Unit { int pm, pn; };
struct Gemm { const bf16_t* A; const bf16_t* Bt; int M, N, K; };

struct StaticOrder {
    int nM, nN, nwg, G, c;
    __host__ __device__ void init(int M, int N, int G_, int c_) { nM = M / BM; nN = N / BM; nwg = nM * nN; G = G_; c = c_; }
    __host__ __device__ bool next(int i, Unit& u) const {
        const long L = (long)i * G + c; if (L >= nwg) return false;
        int wgid = (int)L; { const int q = nwg / NXCD, r = nwg % NXCD, xcd = wgid % NXCD, off = wgid / NXCD; wgid = (xcd < r ? xcd * (q + 1) : r * (q + 1) + (xcd - r) * q) + off; }
        const int nig = WGM * nN, gid = wgid / nig, fm = gid * WGM, gsz = (nM - fm) < WGM ? (nM - fm) : WGM;
        u.pm = fm + ((wgid % nig) % gsz); u.pn = (wgid % nig) / gsz; return true;
    }
    __device__ __forceinline__ void a_ready(const Unit&) const {}
    __device__ __forceinline__ void done(const Unit&) const {}
};
__device__ __forceinline__ unsigned cvt_pk_bf16(float lo, float hi) { unsigned r; asm volatile("v_cvt_pk_bf16_f32 %0, %1, %2" : "=v"(r) : "v"(lo), "v"(hi)); return r; }
typedef float f32x2e __attribute__((ext_vector_type(2)));
DI float silu_f(float x) { return x * __builtin_amdgcn_rcpf(1.f + __expf(-x)); }
struct Epi1 {
    static constexpr bool PERM = true, AFTER_DRAIN = false, HAS_INIT = false;
    const float* rstd; const f32x2e* rot; bf16_t *LX, *LG, *Q, *KK, *V, *RG;
    __device__ __forceinline__ void operator()(const f32x4 (&acc)[2][2][4][2], const Unit& u, int wr, int wc, int fr, int fq) const {
        const int row0 = u.pm * BM + wr * 64 + fr; const int pn = u.pn;
        bf16_t* dst; int ldc, cb, mode; float sc = 1.f;
        if (pn < 4) { dst = LX; ldc = 1024; cb = pn * 256; mode = 0; }
        else if (pn < 8) { dst = LG; ldc = 1024; cb = pn * 256 - 1024; mode = 1; }
        else if (pn < 10) { dst = Q; ldc = 512; cb = pn * 256 - 2048; mode = 2; }
        else if (pn < 12) { dst = KK; ldc = 512; cb = pn * 256 - 2560; mode = 2; sc = 0.125f; }
        else if (pn < 16) { dst = V; ldc = 1024; cb = pn * 256 - 3072; mode = 0; }
        else { dst = RG; ldc = 1024; cb = pn * 256 - 4096; mode = 1; }
        const int col0 = cb + wc * 32 + 8 * fq;
        float rsv[2][4];
#pragma unroll
        for (int ai = 0; ai < 2; ++ai)
#pragma unroll
            for (int m = 0; m < 4; ++m) rsv[ai][m] = rstd[row0 + ai * HALF + m * 16] * sc;
        f32x2e csv[4][4];
#pragma unroll
        for (int ai = 0; ai < 2; ++ai) {
        if (mode == 2) {
#pragma unroll
            for (int m = 0; m < 4; ++m) { const int r = row0 + ai * HALF + m * 16; const f32x2e* cs = rot + (16 + (r & 4095)) * 32 + ((col0 & 63) >> 1);
#pragma unroll
                for (int j = 0; j < 4; ++j) csv[m][j] = cs[j]; }
        }
#pragma unroll
            for (int m = 0; m < 4; ++m) {
                const int r = row0 + ai * HALF + m * 16; const float rs = rsv[ai][m];
                bf16_t* rowp = dst + (size_t)r * ldc + col0;
#pragma unroll
                for (int bj = 0; bj < 2; ++bj) {
                    f32x4 v0 = acc[ai][bj][m][0] * rs, v1 = acc[ai][bj][m][1] * rs;
                    if (mode == 1) {
#pragma unroll
                        for (int j = 0; j < 4; ++j) { v0[j] = silu_f(v0[j]); v1[j] = silu_f(v1[j]); }
                    } else if (mode == 2) {
                        const f32x2e c0 = csv[m][0], c1 = csv[m][1], c2 = csv[m][2], c3 = csv[m][3];
                        float a, b;
                        a = v0[0]; b = v0[1]; v0[0] = a * c0.x - b * c0.y; v0[1] = a * c0.y + b * c0.x;
                        a = v0[2]; b = v0[3]; v0[2] = a * c1.x - b * c1.y; v0[3] = a * c1.y + b * c1.x;
                        a = v1[0]; b = v1[1]; v1[0] = a * c2.x - b * c2.y; v1[1] = a * c2.y + b * c2.x;
                        a = v1[2]; b = v1[3]; v1[2] = a * c3.x - b * c3.y; v1[3] = a * c3.y + b * c3.x;
                    }
                    u32x4 w; w.x = cvt_pk_bf16(v0[0], v0[1]); w.y = cvt_pk_bf16(v0[2], v0[3]); w.z = cvt_pk_bf16(v1[0], v1[1]); w.w = cvt_pk_bf16(v1[2], v1[3]);
                    *(u32x4*)(rowp + bj * HALF) = w;
                }
            }
        }
    }
};
struct Epi5 {
    static constexpr bool PERM = false, AFTER_DRAIN = false, HAS_INIT = false;
    const float* x; float* out;
    __device__ __forceinline__ void operator()(const f32x4 (&acc)[2][2][4][2], const Unit& u, int wr, int wc, int fr, int fq) const {
        const int row0 = u.pm * BM + wr * 64 + fr, col0 = u.pn * BM + wc * 32 + 4 * fq;
#pragma unroll
        for (int ai = 0; ai < 2; ++ai) {
            f32x4 xv[4][2][2];
#pragma unroll
            for (int m = 0; m < 4; ++m) { const size_t off = (size_t)(row0 + ai * HALF + m * 16) * 1024 + col0;
#pragma unroll
                for (int bj = 0; bj < 2; ++bj)
#pragma unroll
                    for (int n = 0; n < 2; ++n) xv[m][bj][n] = *(const f32x4*)(x + off + bj * HALF + n * 16); }
#pragma unroll
            for (int m = 0; m < 4; ++m) { const size_t off = (size_t)(row0 + ai * HALF + m * 16) * 1024 + col0;
#pragma unroll
                for (int bj = 0; bj < 2; ++bj)
#pragma unroll
                    for (int n = 0; n < 2; ++n) *(f32x4*)(out + off + bj * HALF + n * 16) = acc[ai][bj][m][n] + xv[m][bj][n]; }
        }
    }
};

struct Epi5F {
    static constexpr bool PERM = false, AFTER_DRAIN = true, HAS_INIT = true;
    const float* x; float* out; const float* fg; unsigned* xbuf; unsigned* cnt;
    __device__ __forceinline__ void init(f32x4 (&acc)[2][2][4][2], const Unit& u, int wr, int wc, int fr, int fq) const {
        const int row0 = u.pm * BM + wr * 64 + fr, col0 = u.pn * BM + wc * 32 + 4 * fq;
#pragma unroll
        for (int ai = 0; ai < 2; ++ai)
#pragma unroll
            for (int m = 0; m < 4; ++m) { const size_t off = (size_t)(row0 + ai * HALF + m * 16) * 1024 + col0;
#pragma unroll
                for (int bj = 0; bj < 2; ++bj)
#pragma unroll
                    for (int n = 0; n < 2; ++n) acc[ai][bj][m][n] = __builtin_nontemporal_load((const f32x4*)(x + off + bj * HALF + n * 16)); }
    }
    __device__ __forceinline__ void fused(f32x4 (&acc)[2][2][4][2], const Unit& u, int wr, int wc, int fr, int fq, PG8_LAS unsigned char* lds, int wid, int lane) const {
        PG8_LAS float* Pp = (PG8_LAS float*)lds;
        PG8_LAS float* S = (PG8_LAS float*)(lds + 4096);
        const int row0 = u.pm * BM + wr * 64 + fr, col0 = u.pn * BM + wc * 32 + 4 * fq;
#pragma unroll
        for (int ai = 0; ai < 2; ++ai)
#pragma unroll
            for (int m = 0; m < 4; ++m) { float s = 0.f;
#pragma unroll
                for (int bj = 0; bj < 2; ++bj)
#pragma unroll
                    for (int n = 0; n < 2; ++n) { const f32x4 v = acc[ai][bj][m][n]; s += (v[0] * v[0] + v[1] * v[1]) + (v[2] * v[2] + v[3] * v[3]); }
                s += __shfl_xor(s, 16); s += __shfl_xor(s, 32);
                if (fq == 0) Pp[(ai * HALF + wr * 64 + m * 16 + fr) * 4 + wc] = s; }
        asm volatile("s_waitcnt lgkmcnt(0)" ::: "memory"); __builtin_amdgcn_s_barrier(); asm volatile("" ::: "memory");
        const int row = wid * 32 + (lane & 31);
        if (lane < 32) {
            const float t = (Pp[row * 4 + 0] + Pp[row * 4 + 1]) + (Pp[row * 4 + 2] + Pp[row * 4 + 3]);
            unsigned* sl = xbuf + (size_t)(u.pm * BM + row) * 4;
            __hip_atomic_store(sl + u.pn, __float_as_uint(t) | 0x80000000u, __ATOMIC_RELAXED, __HIP_MEMORY_SCOPE_AGENT);
            unsigned w[4]; unsigned sp = 0;
#pragma unroll
            for (int q = 0; q < 4; ++q) w[q] = __hip_atomic_load(sl + q, __ATOMIC_RELAXED, __HIP_MEMORY_SCOPE_AGENT);
            while (!((w[0] & w[1] & w[2] & w[3]) >> 31) && ++sp < (1u << 18)) { __builtin_amdgcn_s_sleep(4);
#pragma unroll
                for (int q = 0; q < 4; ++q) if (!(w[q] >> 31)) w[q] = __hip_atomic_load(sl + q, __ATOMIC_RELAXED, __HIP_MEMORY_SCOPE_AGENT); }
            float tt = 0.f;
#pragma unroll
            for (int q = 0; q < 4; ++q) tt += __uint_as_float(w[q] & 0x7fffffffu);
            S[row] = 1.0f / sqrtf(tt * (1.0f / 1024.0f) + 1e-6f); }
        asm volatile("s_waitcnt vmcnt(0) lgkmcnt(0)" ::: "memory"); __builtin_amdgcn_s_barrier(); asm volatile("" ::: "memory");
        f32x4 gv[2][2];
#pragma unroll
        for (int bj = 0; bj < 2; ++bj)
#pragma unroll
            for (int n = 0; n < 2; ++n) gv[bj][n] = *(const f32x4*)(fg + col0 + bj * HALF + n * 16);
#pragma unroll
        for (int ai = 0; ai < 2; ++ai)
#pragma unroll
            for (int m = 0; m < 4; ++m) { const int r = ai * HALF + wr * 64 + m * 16 + fr; const float rs = S[r]; const size_t off = (size_t)(u.pm * BM + r) * 1024 + col0;
#pragma unroll
                for (int bj = 0; bj < 2; ++bj)
#pragma unroll
                    for (int n = 0; n < 2; ++n) *(f32x4*)(out + off + bj * HALF + n * 16) = acc[ai][bj][m][n] * rs * gv[bj][n]; }
    }
};
template <class Epi, class Sched, bool ALIGN_EPI = false, bool SP2 = false>
__device__ __forceinline__ void gemm_phase(PG8_LAS unsigned char* lds, const Gemm g, const Sched& S, const Epi& E) {
    const int tid = threadIdx.x, wid = __builtin_amdgcn_readfirstlane(tid >> 6), lane = tid & 63, wr = wid >> 2, wc = wid & 3, fr = lane & 15, fq = lane >> 4;
    const int K = g.K, nt = K / BK;
    unsigned voffA[2], voffB[2];
#pragma unroll
    for (int i = 0; i < 2; ++i) { int R, C; stage_rc(tid * 16 + i * 8192, R, C); const int Rb = Epi::PERM ? ((R & ~31) + perm32(R & 31)) : R;
        voffA[i] = (unsigned)(R * K + C) * 2u; voffB[i] = (unsigned)(Rb * K + C) * 2u; }
    const size_t kstep = (size_t)(BK * 2);
    const size_t hstep = (size_t)HALF * K * 2;
    const size_t tstep = 2 * hstep;
    const unsigned ldsw = (unsigned)wid * 1024u;
    const int aoff = lds_byte(wr * 64 + fr, fq * 8), boff = lds_byte(wc * 32 + fr, fq * 8);
#define PG8_SA(b, h) (((b) * 2 + (h)) * HTB)
#define PG8_SB(b, h) ((4 + (b) * 2 + (h)) * HTB)
#define PG8_STAGE(bufoff, gbase, voff) do { _Pragma("unroll") for (int _i = 0; _i < 2; ++_i) \
        __builtin_amdgcn_global_load_lds((const unsigned*)((const char*)(gbase) + (voff)[_i]), (PG8_LAS unsigned*)(lds + (bufoff) + ldsw + _i * 8192), 16, 0, 0); } while (0)
#define PG8_LDA(dst, b, h) do { _Pragma("unroll") for (int m = 0; m < 4; ++m) _Pragma("unroll") for (int k = 0; k < 2; ++k) dst[m][k] = *(const PG8_LAS bf16x8*)(lds + PG8_SA(b, h) + aoff + m * 2048 + k * 1024); } while (0)
#define PG8_LDB(dst, b, h) do { _Pragma("unroll") for (int n = 0; n < 2; ++n) _Pragma("unroll") for (int k = 0; k < 2; ++k) dst[n][k] = *(const PG8_LAS bf16x8*)(lds + PG8_SB(b, h) + boff + n * 2048 + k * 1024); } while (0)
#define PG8_MMA(ai, bj, At, Bt) do { __builtin_amdgcn_s_setprio(1); _Pragma("unroll") for (int m = 0; m < 4; ++m) _Pragma("unroll") for (int n = 0; n < 2; ++n) _Pragma("unroll") for (int k = 0; k < 2; ++k) \
        acc[ai][bj][m][n] = __builtin_amdgcn_mfma_f32_16x16x32_bf16(Bt[n][k], At[m][k], acc[ai][bj][m][n], 0, 0, 0); __builtin_amdgcn_s_setprio(0); } while (0)
#define PG8_WAIT_V(n) asm volatile("s_waitcnt vmcnt(" #n ")" ::: "memory")
#define PG8_WAIT_L(n) asm volatile("s_waitcnt lgkmcnt(" #n ")" ::: "memory")
#define PG8_BAR __builtin_amdgcn_s_barrier()
#define PG8_SCHED __builtin_amdgcn_sched_barrier(0)
    Unit cur, nxt; int ui = 0;
    if (!S.next(0, cur)) return;
    f32x4 acc[2][2][4][2];
#pragma unroll
    for (int a = 0; a < 2; ++a)
#pragma unroll
        for (int b = 0; b < 2; ++b)
#pragma unroll
            for (int m = 0; m < 4; ++m)
#pragma unroll
                for (int n = 0; n < 2; ++n) acc[a][b][m][n] = (f32x4){0.f, 0.f, 0.f, 0.f};
    if constexpr (Epi::HAS_INIT) E.init(acc, cur, wr, wc, fr, fq);
    bf16x8 At[4][2], B0[2][2], B1[2][2];
    const char* cA = (const char*)g.A + (size_t)cur.pm * tstep; const char* cB = (const char*)g.Bt + (size_t)cur.pn * tstep;
    S.a_ready(cur);
    if constexpr (SP2) {
        PG8_STAGE(PG8_SB(0, 0), cB, voffB); PG8_STAGE(PG8_SB(0, 1), cB + hstep, voffB); PG8_STAGE(PG8_SA(0, 0), cA, voffA); PG8_STAGE(PG8_SA(0, 1), cA + hstep, voffA);
        if (wr == 1) PG8_BAR;
        PG8_WAIT_V(2); PG8_BAR;
        PG8_STAGE(PG8_SB(1, 0), cB + kstep, voffB); PG8_STAGE(PG8_SA(1, 0), cA + kstep, voffA); PG8_STAGE(PG8_SB(1, 1), cB + hstep + kstep, voffB);
        PG8_WAIT_V(6); PG8_BAR;
    } else {
        PG8_STAGE(PG8_SB(0, 0), cB, voffB); PG8_STAGE(PG8_SA(0, 0), cA, voffA); PG8_STAGE(PG8_SB(0, 1), cB + hstep, voffB); PG8_STAGE(PG8_SA(0, 1), cA + hstep, voffA);
        if (wr == 1) PG8_BAR;
        PG8_WAIT_V(4); PG8_BAR;
        PG8_STAGE(PG8_SB(1, 0), cB + kstep, voffB); PG8_STAGE(PG8_SA(1, 0), cA + kstep, voffA); PG8_STAGE(PG8_SB(1, 1), cB + hstep + kstep, voffB);
        PG8_WAIT_V(6); PG8_BAR;
    }
    for (;;) {
        const bool has_next = S.next(ui + 1, nxt);
        const char* nA = has_next ? (const char*)g.A + (size_t)nxt.pm * tstep : cA; const char* nB = has_next ? (const char*)g.Bt + (size_t)nxt.pn * tstep : cB;
        for (int t = 0; t < nt; t += 2) {
            const bool last = (t == nt - 2);
            const char* a1 = cA + (size_t)(t + 1) * kstep;
            const char* a2 = last ? nA : cA + (size_t)(t + 2) * kstep; const char* b2 = last ? nB : cB + (size_t)(t + 2) * kstep;
            const char* a3 = a2 + kstep; const char* b3 = b2 + kstep;
            if (last && has_next) S.a_ready(nxt);
            if constexpr (SP2) {
            PG8_LDB(B0, 0, 0); PG8_LDB(B1, 0, 1); PG8_SCHED; PG8_LDA(At, 0, 0); PG8_STAGE(PG8_SA(1, 1), a1 + hstep, voffA);
            PG8_WAIT_V(8); PG8_WAIT_L(0); PG8_BAR; PG8_MMA(0, 0, At, B0); PG8_MMA(0, 1, At, B1); PG8_BAR; PG8_SCHED;
            PG8_LDA(At, 0, 1); PG8_STAGE(PG8_SB(0, 0), b2, voffB); PG8_STAGE(PG8_SB(0, 1), b2 + hstep, voffB); PG8_STAGE(PG8_SA(0, 0), a2, voffA);
            PG8_WAIT_V(8); PG8_WAIT_L(0); PG8_BAR; PG8_MMA(1, 0, At, B0); PG8_MMA(1, 1, At, B1); PG8_BAR; PG8_SCHED;
            PG8_LDB(B0, 1, 0); PG8_LDB(B1, 1, 1); PG8_SCHED; PG8_LDA(At, 1, 0); PG8_STAGE(PG8_SA(0, 1), a2 + hstep, voffA);
            PG8_WAIT_V(8); PG8_WAIT_L(0); PG8_BAR; PG8_MMA(0, 0, At, B0); PG8_MMA(0, 1, At, B1); PG8_BAR; PG8_SCHED;
            PG8_LDA(At, 1, 1); PG8_STAGE(PG8_SB(1, 0), b3, voffB); PG8_STAGE(PG8_SB(1, 1), b3 + hstep, voffB); PG8_STAGE(PG8_SA(1, 0), a3, voffA);
            PG8_WAIT_V(8); PG8_WAIT_L(0); PG8_BAR; PG8_MMA(1, 0, At, B0); PG8_MMA(1, 1, At, B1); PG8_BAR; PG8_SCHED;
            } else {
            PG8_LDB(B0, 0, 0); PG8_SCHED; PG8_LDA(At, 0, 0); PG8_STAGE(PG8_SA(1, 1), a1 + hstep, voffA);
            PG8_WAIT_L(8); PG8_BAR; PG8_WAIT_L(0); PG8_MMA(0, 0, At, B0); PG8_BAR; PG8_SCHED;
            PG8_LDB(B1, 0, 1); PG8_STAGE(PG8_SB(0, 0), b2, voffB);
            PG8_BAR; PG8_WAIT_L(0); PG8_MMA(0, 1, At, B1); PG8_BAR;
            PG8_LDA(At, 0, 1); PG8_STAGE(PG8_SA(0, 0), a2, voffA);
            PG8_BAR; PG8_WAIT_L(0); PG8_MMA(1, 0, At, B0); PG8_BAR; PG8_SCHED;
            PG8_STAGE(PG8_SB(0, 1), b2 + hstep, voffB);
            PG8_WAIT_V(6); PG8_BAR; PG8_MMA(1, 1, At, B1); PG8_BAR;
            PG8_LDB(B0, 1, 0); PG8_SCHED; PG8_LDA(At, 1, 0); PG8_STAGE(PG8_SA(0, 1), a2 + hstep, voffA);
            PG8_WAIT_L(8); PG8_BAR; PG8_WAIT_L(0); PG8_MMA(0, 0, At, B0); PG8_BAR; PG8_SCHED;
            PG8_LDB(B1, 1, 1); PG8_STAGE(PG8_SB(1, 0), b3, voffB);
            PG8_BAR; PG8_WAIT_L(0); PG8_MMA(0, 1, At, B1); PG8_BAR;
            PG8_LDA(At, 1, 1); PG8_STAGE(PG8_SA(1, 0), a3, voffA);
            PG8_BAR; PG8_WAIT_L(0); PG8_MMA(1, 0, At, B0); PG8_BAR; PG8_SCHED;
            PG8_STAGE(PG8_SB(1, 1), b3 + hstep, voffB);
            PG8_WAIT_V(6); PG8_BAR; PG8_MMA(1, 1, At, B1); PG8_BAR;
            }
        }
        if constexpr (ALIGN_EPI) { if (wr == 0) PG8_BAR; }
        if constexpr (!Epi::AFTER_DRAIN) { E(acc, cur, wr, wc, fr, fq); S.done(cur); }
        if (!has_next) break;
#pragma unroll
        for (int a = 0; a < 2; ++a)
#pragma unroll
            for (int b = 0; b < 2; ++b)
#pragma unroll
                for (int m = 0; m < 4; ++m)
#pragma unroll
                    for (int n = 0; n < 2; ++n) acc[a][b][m][n] = (f32x4){0.f, 0.f, 0.f, 0.f};
        cur = nxt; cA = nA; cB = nB; ++ui;
        if constexpr (ALIGN_EPI) { if (wr == 1) PG8_BAR; }
    }
    PG8_WAIT_V(0);
    if constexpr (!ALIGN_EPI) { if (wr == 0) PG8_BAR; }
    PG8_BAR;
    if constexpr (Epi::AFTER_DRAIN) { E.fused(acc, cur, wr, wc, fr, fq, lds, wid, lane); S.done(cur); }
#undef PG8_SA
#undef PG8_SB
#undef PG8_STAGE
#undef PG8_LDA
#undef PG8_LDB
#undef PG8_MMA
#undef PG8_WAIT_V
#undef PG8_WAIT_L
#undef PG8_BAR
#undef PG8_SCHED
}
}
constexpr int BATCH = 4, SEQ = 4096, DM = 1024, NMETA = 16, MROWS = BATCH * SEQ;
constexpr int NHD = 8, LBLK = 128, DK = 64, DV = 128, CHK = 128, NCHK = SEQ / CHK;
constexpr int INW = 5120, MIXW = 2048, MPW = 2560;
constexpr int TPOS = NMETA + SEQ;
constexpr float EPSN = 1e-6f;
constexpr size_t MiB = 1u << 20;
constexpr size_t WS_RSTD = 0;
constexpr size_t WS_SP = 64 * 1024;
constexpr size_t WS_MSLOT = 248 * MiB + 512 * 1024;
constexpr size_t WS_HMETA = 68 * 1024;
constexpr size_t WS_METAP = 72 * 1024;
constexpr size_t WS_BAR = 232 * 1024;
constexpr size_t WS_CNT = WS_BAR + 16384;
constexpr size_t WS_PCNT = WS_CNT + 4096 + 64;
constexpr size_t WS_ZERO_BYTES = 16384 + 4096 + 64 + 256;
constexpr size_t WS_KVM = 256 * 1024;
constexpr size_t WS_WGT = 512 * 1024;
constexpr size_t WS_ROT = 1 * MiB;
constexpr size_t WS_LSUM = 2 * MiB + 512 * 1024;
constexpr size_t WS_LCARRY = 3 * MiB + 512 * 1024;
constexpr size_t WS_W2T = 4 * MiB;
constexpr size_t WS_Y = 8 * MiB;
constexpr size_t WS_HB = 8 * MiB;
constexpr size_t WS_W1T = 40 * MiB;
constexpr size_t WS_LX = 72 * MiB, WS_LG = 104 * MiB, WS_Q = 136 * MiB, WS_KK = 152 * MiB, WS_V = 168 * MiB, WS_RG = 200 * MiB;
constexpr size_t WS_RPREV = 232 * MiB;
constexpr size_t WS_XBUF = 248 * MiB;
constexpr size_t WS_END = 249 * MiB;

typedef unsigned short bf16;
typedef unsigned u32x4 __attribute__((ext_vector_type(4)));
typedef float f32x4 __attribute__((ext_vector_type(4)));
typedef float f32x2 __attribute__((ext_vector_type(2)));
typedef short bf16x8 __attribute__((ext_vector_type(8)));
typedef short s16x4 __attribute__((ext_vector_type(4)));
#define LAS __attribute__((address_space(3)))

DI float bf2f(bf16 b) { return __uint_as_float(((unsigned)b) << 16); }
typedef __bf16 bf16x2_t __attribute__((ext_vector_type(2)));
DI bf16 f2bf(float f) { return __builtin_bit_cast(unsigned short, (__bf16)f); }
DI unsigned pk2(float lo, float hi) { bf16x2_t v = {(__bf16)lo, (__bf16)hi}; return __builtin_bit_cast(unsigned, v); }
DI float sigm(float x) { return 1.f / (1.f + __expf(-x)); }
DI float loggh(int h) { return log1pf(-exp2f(-5.0f - (float)h)); }
DI int w1_src_col(int np) { if (np >= 2048 && np < 3072) { const int hb = np & ~63, c = np & 63; return hb + (c >> 1) + 32 * (c & 1); } return np; }
DI int metap_src_col(int j) { return j < 1024 ? j : (j < 1536 ? 2560 + (j - 1024) : 3072 + (j - 1536)); }
DI float wave_sum(float v) {
#pragma unroll
    for (int o = 1; o < 64; o <<= 1) v += __shfl_xor(v, o);
    return v;
}

struct Ptrs {
    const float *x, *meta, *ngain, *w_in, *conv_w, *conv_b, *w_rg, *b_rg, *w_ig, *b_ig, *lam, *rng, *w_out, *fgain;
    float* out; unsigned char* ws;
};
#define WSP(T, off) ((T*)(P.ws + (off)))

DI void row_to_bf16(const float* xrow, bf16* orow, float* rstd_out, int lane) {
    const f32x4* xr = (const f32x4*)xrow + lane; f32x4 v[4]; float s = 0.f;
#pragma unroll
    for (int j = 0; j < 4; ++j) { v[j] = xr[64 * j]; s += (v[j].x * v[j].x + v[j].y * v[j].y) + (v[j].z * v[j].z + v[j].w * v[j].w); }
    s = wave_sum(s);
    if (lane == 0) *rstd_out = 1.0f / sqrtf(s * (1.0f / DM) + EPSN);
    unsigned long long* o8 = (unsigned long long*)orow + lane;
#pragma unroll
    for (int j = 0; j < 4; ++j) o8[64 * j] = (unsigned long long)pk2(v[j].x, v[j].y) | ((unsigned long long)pk2(v[j].z, v[j].w) << 32);
}
DI void final_norm_row(float* row, const float* g, int lane) {
    f32x4* xr = (f32x4*)row + lane; const f32x4* gr = (const f32x4*)g + lane; f32x4 v[4]; float s = 0.f;
#pragma unroll
    for (int j = 0; j < 4; ++j) { v[j] = xr[64 * j]; s += (v[j].x * v[j].x + v[j].y * v[j].y) + (v[j].z * v[j].z + v[j].w * v[j].w); }
    s = wave_sum(s); const float rs = 1.0f / sqrtf(s * (1.0f / DM) + EPSN);
#pragma unroll
    for (int j = 0; j < 4; ++j) xr[64 * j] = v[j] * rs * gr[64 * j];
}
DI void rot_sp_entry(const Ptrs& P, int idx) {
    if (idx < TPOS * 32) { const int pos = idx >> 5, i = idx & 31; const double inv = pow(10000.0, -(double)i / 32.0); const double ang = (double)pos * inv;
        WSP(f32x2, WS_ROT)[idx] = (f32x2){(float)cos(ang), (float)sin(ang)}; }
    else { const int c = idx - TPOS * 32; WSP(float, WS_SP)[c] = log1pf(expf(-P.lam[c])); }
}

__global__ void n0_rows(Ptrs P) { const int gw = (blockIdx.x * blockDim.x + threadIdx.x) >> 6, lane = threadIdx.x & 63; if (gw < MROWS) row_to_bf16(P.x + (size_t)gw * DM, WSP(bf16, WS_HB) + (size_t)gw * DM, WSP(float, WS_RSTD) + gw, lane); }
__global__ void n0_misc(Ptrs P) { const int idx = blockIdx.x * blockDim.x + threadIdx.x; if (idx < TPOS * 32 + 1024) rot_sp_entry(P, idx); }
__global__ void n0_w1t(Ptrs P) { const int idx = blockIdx.x * blockDim.x + threadIdx.x; if (idx >= INW * DM) return; const int np = idx >> 10, k = idx & 1023;
    WSP(bf16, WS_W1T)[idx] = f2bf(P.ngain[k] * P.w_in[(size_t)k * INW + w1_src_col(np)]); }
__global__ void n0_w2t(Ptrs P) { const int idx = blockIdx.x * blockDim.x + threadIdx.x; if (idx >= DM * MIXW) return; const int n = idx >> 11, k = idx & 2047;
    WSP(bf16, WS_W2T)[idx] = f2bf(P.w_out[(size_t)k * DM + n]); }
__global__ void n0_wgt(Ptrs P) { const int idx = blockIdx.x * blockDim.x + threadIdx.x; if (idx >= 2 * 8 * 128 * 128) return;
    const int g = idx >> 17, hh = (idx >> 14) & 7, n = (idx >> 7) & 127, k = idx & 127; const float* w = g ? P.w_ig : P.w_rg;
    WSP(bf16, WS_WGT)[idx] = f2bf(-1.44269504089f * w[(hh * 128 + k) * 128 + n]); }
__global__ void n0_meta(Ptrs P) { const int idx = blockIdx.x * blockDim.x + threadIdx.x; if (idx >= NMETA * MPW) return; const int r = idx / MPW, j = idx % MPW; const int col = metap_src_col(j);
    float ss = 0.f; for (int k = 0; k < DM; ++k) { const float v = P.meta[r * DM + k]; ss += v * v; }
    const float rs = 1.0f / sqrtf(ss * (1.0f / DM) + EPSN); float acc = 0.f;
    for (int k = 0; k < DM; ++k) acc += P.meta[r * DM + k] * rs * P.ngain[k] * P.w_in[(size_t)k * INW + col];
    WSP(float, WS_METAP)[idx] = acc; }
__global__ void n1_gemm1(Ptrs P) {
    const size_t idx = (size_t)blockIdx.x * blockDim.x + threadIdx.x; if (idx >= (size_t)MROWS * (INW / 2)) return;
    const int row = (int)(idx / (INW / 2)), p = (int)(idx % (INW / 2)), np = 2 * p;
    const u32x4* a = (const u32x4*)(WSP(bf16, WS_HB) + (size_t)row * DM); const u32x4* b0 = (const u32x4*)(WSP(bf16, WS_W1T) + (size_t)np * DM); const u32x4* b1 = b0 + DM / 8;
    float s0 = 0.f, s1 = 0.f;
    for (int k8 = 0; k8 < DM / 8; ++k8) { const u32x4 av = a[k8], v0 = b0[k8], v1 = b1[k8];
#pragma unroll
        for (int j = 0; j < 4; ++j) { const float al = __uint_as_float(av[j] << 16), ah = __uint_as_float(av[j] & 0xffff0000u);
            s0 += al * __uint_as_float(v0[j] << 16) + ah * __uint_as_float(v0[j] & 0xffff0000u); s1 += al * __uint_as_float(v1[j] << 16) + ah * __uint_as_float(v1[j] & 0xffff0000u); } }
    const float rs = WSP(float, WS_RSTD)[row]; s0 *= rs; s1 *= rs;
    bf16* dst; int ldc, col;
    if (np < 1024) { dst = WSP(bf16, WS_LX); ldc = 1024; col = np; }
    else if (np < 2048) { dst = WSP(bf16, WS_LG); ldc = 1024; col = np - 1024; s0 = s0 / (1.f + __expf(-s0)); s1 = s1 / (1.f + __expf(-s1)); }
    else if (np < 3072) { const bool isk = np >= 2560; dst = isk ? WSP(bf16, WS_KK) : WSP(bf16, WS_Q); ldc = 512; col = np - (isk ? 2560 : 2048);
        const int i = (np & 63) >> 1, pos = NMETA + (row & (SEQ - 1)); const f32x2 cs = WSP(f32x2, WS_ROT)[pos * 32 + i]; const float sc = isk ? 0.125f : 1.f;
        const float a1 = s0, a2 = s1; s0 = (a1 * cs.x - a2 * cs.y) * sc; s1 = (a1 * cs.y + a2 * cs.x) * sc; }
    else if (np < 4096) { dst = WSP(bf16, WS_V); ldc = 1024; col = np - 3072; }
    else { dst = WSP(bf16, WS_RG); ldc = 1024; col = np - 4096; s0 = s0 / (1.f + __expf(-s0)); s1 = s1 / (1.f + __expf(-s1)); }
    *(unsigned*)(dst + (size_t)row * ldc + col) = pk2(s0, s1);
}
__global__ void __launch_bounds__(128) n_lru(Ptrs P) {
    extern __shared__ float nsm[]; float* wr = nsm; float* wi = nsm + 128 * 128; float* xcs = nsm + 2 * 128 * 128;
    const int b = blockIdx.x >> 3, hh = blockIdx.x & 7, c = threadIdx.x, ch = hh * 128 + c;
    for (int i = c; i < 128 * 128; i += 128) { wr[i] = P.w_rg[hh * 16384 + i]; wi[i] = P.w_ig[hh * 16384 + i]; }
    const float cw0 = P.conv_w[ch], cw1 = P.conv_w[1024 + ch], cw2 = P.conv_w[2048 + ch], cw3 = P.conv_w[3072 + ch], cb = P.conv_b[ch];
    const float brg = P.b_rg[ch], big = P.b_ig[ch], sp = WSP(float, WS_SP)[ch];
    float x0 = 0.f, x1 = 0.f, x2 = 0.f, h = 0.f;
    for (int tt = 0; tt < TPOS; ++tt) {
        const size_t row = (size_t)b * SEQ + (tt - NMETA);
        const float xin = tt < NMETA ? WSP(float, WS_METAP)[tt * MPW + ch] : bf2f(WSP(bf16, WS_LX)[row * 1024 + ch]);
        const float xcv = cb + cw0 * x0 + cw1 * x1 + cw2 * x2 + cw3 * xin; x0 = x1; x1 = x2; x2 = xin;
        __syncthreads(); xcs[c] = xcv; __syncthreads();
        float rp = brg, ip = big;
        for (int ci = 0; ci < 128; ++ci) { const float xv = xcs[ci]; rp += xv * wr[ci * 128 + c]; ip += xv * wi[ci * 128 + c]; }
        const float r = sigm(rp), ig = sigm(ip), la = -8.0f * r * sp, a = expf(la), beta = sqrtf(-expm1f(2.0f * la));
        h = a * h + beta * ig * xcv;
        if (tt >= NMETA) WSP(bf16, WS_Y)[row * MIXW + ch] = f2bf(h * bf2f(WSP(bf16, WS_LG)[row * 1024 + ch]));
    }
}
__global__ void __launch_bounds__(128) n_ret(Ptrs P) {
    __shared__ float ks[64], qs[64], red[4];
    const int b = blockIdx.x >> 3, h = blockIdx.x & 7, e = threadIdx.x, lane = e & 63, wv = e >> 6;
    const float g = expf(loggh(h)), gn = P.rng[h * 128 + e];
    float S[64];
#pragma unroll
    for (int d = 0; d < 64; ++d) S[d] = 0.f;
    for (int tt = 0; tt < TPOS; ++tt) {
        const size_t row = (size_t)b * SEQ + (tt - NMETA); float v;
        __syncthreads();
        if (tt < NMETA) { const float* mp = WSP(float, WS_METAP) + tt * MPW;
            if (e < 32) { const float x1 = mp[1024 + h * 64 + e], x2 = mp[1024 + h * 64 + 32 + e]; const f32x2 cs = WSP(f32x2, WS_ROT)[tt * 32 + e];
                ks[2 * e] = (x1 * cs.x - x2 * cs.y) * 0.125f; ks[2 * e + 1] = (x1 * cs.y + x2 * cs.x) * 0.125f; qs[2 * e] = 0.f; qs[2 * e + 1] = 0.f; }
            v = mp[1536 + h * 128 + e]; }
        else { if (e < 64) { ks[e] = bf2f(WSP(bf16, WS_KK)[row * 512 + h * 64 + e]); qs[e] = bf2f(WSP(bf16, WS_Q)[row * 512 + h * 64 + e]); }
            v = bf2f(WSP(bf16, WS_V)[row * 1024 + h * 128 + e]); }
        __syncthreads();
        float o = 0.f;
#pragma unroll
        for (int d = 0; d < 64; ++d) { S[d] = g * S[d] + ks[d] * v; o += qs[d] * S[d]; }
        if (tt >= NMETA) {
            float s = wave_sum(o); if (lane == 0) red[wv] = s; __syncthreads(); const float mu = (red[0] + red[1]) * (1.0f / 128.0f);
            const float dlt = o - mu; float q = wave_sum(dlt * dlt); if (lane == 0) red[2 + wv] = q; __syncthreads(); const float var = (red[2] + red[3]) * (1.0f / 128.0f);
            const float y = dlt * (1.0f / sqrtf(var + EPSN)) * gn * bf2f(WSP(bf16, WS_RG)[row * 1024 + h * 128 + e]);
            WSP(bf16, WS_Y)[row * MIXW + 1024 + h * 128 + e] = f2bf(y);
        }
    }
}
__global__ void n5_gemm2(Ptrs P) {
    const size_t idx = (size_t)blockIdx.x * blockDim.x + threadIdx.x; if (idx >= (size_t)MROWS * (DM / 2)) return;
    const int row = (int)(idx / (DM / 2)), n = 2 * (int)(idx % (DM / 2));
    const u32x4* a = (const u32x4*)(WSP(bf16, WS_Y) + (size_t)row * MIXW); const u32x4* b0 = (const u32x4*)(WSP(bf16, WS_W2T) + (size_t)n * MIXW); const u32x4* b1 = b0 + MIXW / 8;
    float s0 = 0.f, s1 = 0.f;
    for (int k8 = 0; k8 < MIXW / 8; ++k8) { const u32x4 av = a[k8], v0 = b0[k8], v1 = b1[k8];
#pragma unroll
        for (int j = 0; j < 4; ++j) { const float al = __uint_as_float(av[j] << 16), ah = __uint_as_float(av[j] & 0xffff0000u);
            s0 += al * __uint_as_float(v0[j] << 16) + ah * __uint_as_float(v0[j] & 0xffff0000u); s1 += al * __uint_as_float(v1[j] << 16) + ah * __uint_as_float(v1[j] & 0xffff0000u); } }
    const size_t o = (size_t)row * DM + n; P.out[o] = P.x[o] + s0; P.out[o + 1] = P.x[o + 1] + s1;
}
__global__ void n6_norm(Ptrs P) { const int gw = (blockIdx.x * blockDim.x + threadIdx.x) >> 6, lane = threadIdx.x & 63; if (gw < MROWS) final_norm_row(P.out + (size_t)gw * DM, P.fgain, lane); }
constexpr int NT = 512;
constexpr int LDS_BYTES = 147456;
DI s16x4 tr_read(const LAS unsigned char* p) { return __builtin_amdgcn_ds_read_tr16_b64_v4i16((LAS s16x4*)p); }
DI bf16x8 cat8(s16x4 a, s16x4 b) { return __builtin_shufflevector(a, b, 0, 1, 2, 3, 4, 5, 6, 7); }
#define MFMA16(a, b, c) __builtin_amdgcn_mfma_f32_16x16x32_bf16((a), (b), (c), 0, 0, 0)

template <int CMAP>
DI void p0_transpose_item(const float* W, int K, int N, int ldw, bf16* WT, const float* gain, LAS float* scr, int item, int lane, float scale = 1.0f) {
    const int nblk = N / 32, kb = item / nblk, nb = item % nblk, k0 = 64 * kb, n0 = 32 * nb;
    const int scol = CMAP ? w1_src_col(n0 + (lane & 31)) : n0 + (lane & 31);
    float wv[32];
#pragma unroll
    for (int i = 0; i < 32; ++i) wv[i] = __builtin_nontemporal_load(W + (size_t)(k0 + 2 * i + (lane >> 5)) * ldw + scol);
#pragma unroll
    for (int i = 0; i < 32; ++i) { const int kk = 2 * i + (lane >> 5); float v = wv[i] * scale; if (gain) v *= gain[k0 + kk]; scr[kk * 33 + (lane & 31)] = v; }
    asm volatile("s_waitcnt lgkmcnt(0)" ::: "memory");
    const int c = lane & 7;
#pragma unroll
    for (int j = 0; j < 4; ++j) { const int n = (lane >> 3) + 8 * j; const LAS float* s = scr + (8 * c) * 33 + n;
        u32x4 o; o.x = pk2(s[0 * 33], s[1 * 33]); o.y = pk2(s[2 * 33], s[3 * 33]); o.z = pk2(s[4 * 33], s[5 * 33]); o.w = pk2(s[6 * 33], s[7 * 33]);
        *(u32x4*)(WT + (size_t)(n0 + n) * K + k0 + 8 * c) = o; }
    asm volatile("s_waitcnt lgkmcnt(0)" ::: "memory");
}
DI void p0_meta_block(const Ptrs& P, LAS unsigned char* lds, int blk, int tid) {
    LAS float* mu = (LAS float*)lds;
    LAS float* red = (LAS float*)(lds + 65536);
    const int wave = tid >> 6, lane = tid & 63;
    for (int rr = 0; rr < 2; ++rr) { const int r = 2 * wave + rr; const f32x4* xr = (const f32x4*)(P.meta + r * DM) + lane; const f32x4* gr = (const f32x4*)P.ngain + lane; f32x4 v[4]; float s = 0.f;
#pragma unroll
        for (int j = 0; j < 4; ++j) { v[j] = xr[64 * j]; s += (v[j].x * v[j].x + v[j].y * v[j].y) + (v[j].z * v[j].z + v[j].w * v[j].w); }
        s = wave_sum(s); const float rs = 1.0f / sqrtf(s * (1.0f / DM) + EPSN);
#pragma unroll
        for (int j = 0; j < 4; ++j) *(LAS f32x4*)(mu + r * 1024 + 4 * (lane + 64 * j)) = v[j] * rs * gr[64 * j]; }
    __syncthreads();
    const int c2 = tid & 7, kg = tid >> 3; const int col = metap_src_col(16 * blk + 2 * c2);
    float acc0[16], acc1[16]; f32x2 wv[16];
#pragma unroll
    for (int r = 0; r < 16; ++r) { acc0[r] = 0.f; acc1[r] = 0.f; }
#pragma unroll
    for (int i = 0; i < 16; ++i) wv[i] = __builtin_nontemporal_load((const f32x2*)(P.w_in + (size_t)(kg + 64 * i) * INW + col));
#pragma unroll
    for (int i = 0; i < 16; ++i) { const int k = kg + 64 * i;
#pragma unroll
        for (int r = 0; r < 16; ++r) { const float m = mu[r * 1024 + k]; acc0[r] += m * wv[i].x; acc1[r] += m * wv[i].y; } }
#pragma unroll
    for (int r = 0; r < 16; ++r) { red[(kg * 16 + r) * 16 + 2 * c2] = acc0[r]; red[(kg * 16 + r) * 16 + 2 * c2 + 1] = acc1[r]; }
    __syncthreads();
    if (tid < 256) { const int r = tid >> 4, cc = tid & 15; float s = 0.f; for (int g = 0; g < 64; ++g) s += red[(g * 16 + r) * 16 + cc];
        WSP(float, WS_METAP)[r * MPW + 16 * blk + cc] = s; }
    __syncthreads();
}
DI void p0_prologue(const Ptrs& P, LAS unsigned char* lds, int tid) {
    const int wave = tid >> 6, lane = tid & 63, G = gridDim.x;
    if ((int)blockIdx.x < MPW / 16) p0_meta_block(P, lds, blockIdx.x, tid);
    LAS float* scr = (LAS float*)(lds + wave * 16384);
    const int gw = blockIdx.x * 8 + wave, NGW = G * 8;
    constexpr int I1 = (DM / 64) * (INW / 32), I2 = (MIXW / 64) * (DM / 32), IG = 2 * 8;
    for (int it = gw; it < I1 + I2 + 16 * 8; it += NGW) {
        int r = it;
        if (r < I1) { p0_transpose_item<1>(P.w_in, DM, INW, INW, WSP(bf16, WS_W1T), P.ngain, scr, r, lane); continue; } r -= I1;
        if (r < I2) { p0_transpose_item<0>(P.w_out, MIXW, DM, DM, WSP(bf16, WS_W2T), nullptr, scr, r, lane); continue; } r -= I2;
        const int mat = r >> 3, sub = r & 7; const float* w = (mat < 8 ? P.w_rg : P.w_ig) + (mat & 7) * 16384;
        p0_transpose_item<0>(w, 128, 128, 128, WSP(bf16, WS_WGT) + mat * 16384, nullptr, scr, sub, lane, -1.44269504089f);
    }
    (void)IG;
    for (int m0 = gw; m0 < MROWS; m0 += 4 * NGW) {
        f32x4 v[4][4];
#pragma unroll
        for (int r = 0; r < 4; ++r) { const int m = m0 + r * NGW; if (m < MROWS) { const f32x4* xr = (const f32x4*)(P.x + (size_t)m * DM) + lane;
#pragma unroll
            for (int j = 0; j < 4; ++j) v[r][j] = __builtin_nontemporal_load(xr + 64 * j); } }
#pragma unroll
        for (int r = 0; r < 4; ++r) { const int m = m0 + r * NGW; if (m < MROWS) { float ss = 0.f;
#pragma unroll
            for (int j = 0; j < 4; ++j) ss += (v[r][j].x * v[r][j].x + v[r][j].y * v[r][j].y) + (v[r][j].z * v[r][j].z + v[r][j].w * v[r][j].w);
            ss = wave_sum(ss); if (lane == 0) WSP(float, WS_RSTD)[m] = 1.0f / sqrtf(ss * (1.0f / DM) + EPSN);
            unsigned long long* o8 = (unsigned long long*)(WSP(bf16, WS_HB) + (size_t)m * DM) + lane;
#pragma unroll
            for (int j = 0; j < 4; ++j) o8[64 * j] = (unsigned long long)pk2(v[r][j].x, v[r][j].y) | ((unsigned long long)pk2(v[r][j].z, v[r][j].w) << 32); } }
    }
    for (int idx = blockIdx.x * NT + tid; idx < TPOS * 32 + 1024; idx += G * NT) rot_sp_entry(P, idx);
    for (int idx = blockIdx.x * NT + tid; idx < 65536; idx += G * NT) WSP(unsigned, WS_XBUF)[idx] = 0u;
    for (int idx = blockIdx.x * NT + tid; idx < BATCH * NCHK * 1024 + 1024; idx += G * NT) { if (idx < BATCH * NCHK * 1024) WSP(unsigned long long, WS_LSUM)[idx] = 0ull; else WSP(unsigned long long, WS_MSLOT)[idx - BATCH * NCHK * 1024] = 0ull; }
}

DI float fsig(float x) { return __builtin_amdgcn_rcpf(1.0f + __expf(-x)); }
DI float beta_from(float la, float a) {
    const float y = 2.0f * la;
    float p = 1.0f + y * (1.0f / 7.0f); p = 1.0f + y * (1.0f / 6.0f) * p; p = 1.0f + y * (1.0f / 5.0f) * p; p = 1.0f + y * (1.0f / 4.0f) * p; p = 1.0f + y * (1.0f / 3.0f) * p; p = 1.0f + y * 0.5f * p;
    const float small = -y * p, big = 1.0f - a * a;
    return __builtin_amdgcn_sqrtf(y > -0.5f ? small : big);
}
DI float fsig2(float z2) { return __builtin_amdgcn_rcpf(1.0f + __builtin_amdgcn_exp2f(z2)); }
DI float beta_from2(float la2, float a) {
    const float y = 1.38629436112f * la2, q = y * y;
    const float s1 = 1.0f + 0.5f * y, s2 = (1.0f / 6.0f) + (1.0f / 24.0f) * y, p = s1 + q * s2;
    const float small = -y * p, big = 1.0f - a * a;
    return __builtin_amdgcn_sqrtf(y > -0.2f ? small : big);
}
struct LruConst { bf16x8 br[4], bi[4]; float brg, big, sp2; int hh; };
DI void lru_const_load(const Ptrs& P, LruConst& C, int hh, int tid) {
    const int wave = __builtin_amdgcn_readfirstlane(tid >> 6), lane = tid & 63, li = lane & 15, lq = lane >> 4, cl = 16 * wave + li, ch = hh * 128 + cl;
#pragma unroll
    for (int kb = 0; kb < 4; ++kb) { C.br[kb] = *(const bf16x8*)(WSP(bf16, WS_WGT) + ((size_t)(0 * 8 + hh) * 128 + cl) * 128 + 32 * kb + 8 * lq);
                                      C.bi[kb] = *(const bf16x8*)(WSP(bf16, WS_WGT) + ((size_t)(1 * 8 + hh) * 128 + cl) * 128 + 32 * kb + 8 * lq); }
    C.brg = -1.44269504089f * P.b_rg[ch]; C.big = -1.44269504089f * P.b_ig[ch]; C.sp2 = -8.0f * 1.44269504089f * WSP(float, WS_SP)[ch]; C.hh = hh;
}
DI void lru_tile(const Ptrs& P, LAS unsigned char* lds, int b, int n, int hh, int tid, LruConst& C) {
    LAS unsigned char* XA = lds;
    LAS float* XF = (LAS float*)(lds + 34816);
    const int wave = __builtin_amdgcn_readfirstlane(tid >> 6), lane = tid & 63, li = lane & 15, lq = lane >> 4;
    const size_t row0 = (size_t)b * SEQ + (size_t)n * CHK;
    const int cl = 16 * wave + li, ch = hh * 128 + cl;
    const int cg = tid & 15, ch0 = hh * 128 + cg * 8, tb = tid >> 4;
    if (C.hh != hh) lru_const_load(P, C, hh, tid);
    f32x4 cw[4][2], cbv[2];
#pragma unroll
    for (int k = 0; k < 4; ++k) { cw[k][0] = *(const f32x4*)(P.conv_w + k * 1024 + ch0); cw[k][1] = *(const f32x4*)(P.conv_w + k * 1024 + ch0 + 4); }
    cbv[0] = *(const f32x4*)(P.conv_b + ch0); cbv[1] = *(const f32x4*)(P.conv_b + ch0 + 4);
    u32x4 raw[4][4], lgraw[4];
#pragma unroll
    for (int it = 0; it < 4; ++it) lgraw[it] = __builtin_nontemporal_load((const u32x4*)(WSP(bf16, WS_LG) + (row0 + tb + 32 * it) * 1024 + ch0));
#pragma unroll
    for (int it = 0; it < 4; ++it)
#pragma unroll
        for (int k = 0; k < 4; ++k) {
            const int tg = n * CHK + tb + 32 * it - 3 + k;
            if (tg >= 0) raw[it][k] = *(const u32x4*)(WSP(bf16, WS_LX) + ((size_t)b * SEQ + tg) * 1024 + ch0);
            else { const float* mp = WSP(float, WS_METAP) + (NMETA + tg) * MPW + ch0; const f32x4 m0 = *(const f32x4*)mp, m1 = *(const f32x4*)(mp + 4);
                raw[it][k] = (u32x4){pk2(m0[0], m0[1]), pk2(m0[2], m0[3]), pk2(m1[0], m1[1]), pk2(m1[2], m1[3])}; }
        }
    __syncthreads();
#pragma unroll
    for (int it = 0; it < 4; ++it) {
        const int t = tb + 32 * it;
        f32x4 x0 = cbv[0], x1 = cbv[1];
#pragma unroll
        for (int k = 0; k < 4; ++k) { const u32x4 w = raw[it][k];
            const f32x4 lo = (f32x4){__uint_as_float(w[0] << 16), __uint_as_float(w[0] & 0xffff0000u), __uint_as_float(w[1] << 16), __uint_as_float(w[1] & 0xffff0000u)};
            const f32x4 hi = (f32x4){__uint_as_float(w[2] << 16), __uint_as_float(w[2] & 0xffff0000u), __uint_as_float(w[3] << 16), __uint_as_float(w[3] & 0xffff0000u)};
            x0 += cw[k][0] * lo; x1 += cw[k][1] * hi; }
        u32x4 pk; pk.x = pk2(x0[0], x0[1]); pk.y = pk2(x0[2], x0[3]); pk.z = pk2(x1[0], x1[1]); pk.w = pk2(x1[2], x1[3]);
        *(LAS u32x4*)(XA + t * 272 + cg * 16) = pk;
        *(LAS f32x4*)(XF + t * 132 + cg * 8) = x0;
        *(LAS f32x4*)(XF + t * 132 + cg * 8 + 4) = x1;
    }
    const float brg = C.brg, big = C.big, sp2 = C.sp2;
    float carry = 0.f;
    __syncthreads();
    f32x4 ar[8], ai[8];
#pragma unroll
    for (int m = 0; m < 8; ++m) { ar[m] = (f32x4){brg, brg, brg, brg}; ai[m] = (f32x4){big, big, big, big};
#pragma unroll
        for (int kb = 0; kb < 4; ++kb) { const bf16x8 a = *(const LAS bf16x8*)(XA + (16 * m + li) * 272 + (32 * kb + 8 * lq) * 2);
            ar[m] = MFMA16(a, C.br[kb], ar[m]); ai[m] = MFMA16(a, C.bi[kb], ai[m]); } }
    float ptot = 1.f;
#pragma unroll
    for (int m = 0; m < 8; ++m) {
        float a[4], u[4];
#pragma unroll
        for (int rg = 0; rg < 4; ++rg) { const int t = 16 * m + 4 * lq + rg; const float xcv = XF[t * 132 + cl];
            const float r = fsig2(ar[m][rg]), ig = fsig2(ai[m][rg]), la2 = r * sp2;
            a[rg] = __builtin_amdgcn_exp2f(la2); u[rg] = beta_from2(la2, a[rg]) * ig * xcv; }
        float A = a[0], H = u[0];
#pragma unroll
        for (int rg = 1; rg < 4; ++rg) { H = a[rg] * H + u[rg]; A *= a[rg]; }
        const float A1 = __shfl_up(A, 16), H1 = __shfl_up(H, 16);
        if (lq >= 1) { H = A * H1 + H; A = A * A1; }
        const float A2 = __shfl_up(A, 32), H2 = __shfl_up(H, 32);
        if (lq >= 2) { H = A * H2 + H; A = A * A2; }
        float Ae = __shfl_up(A, 16), He = __shfl_up(H, 16); if (lq == 0) { Ae = 1.f; He = 0.f; }
        const float At = __shfl(A, li + 48), Ht = __shfl(H, li + 48);
        float hin = He + Ae * carry, pin = Ae * ptot;
#pragma unroll
        for (int rg = 0; rg < 4; ++rg) { hin = a[rg] * hin + u[rg]; pin *= a[rg]; ar[m][rg] = hin; ai[m][rg] = pin; }
        carry = Ht + At * carry; ptot *= At;
    }
    unsigned long long* lsum = WSP(unsigned long long, WS_LSUM); unsigned long long* mslot = WSP(unsigned long long, WS_MSLOT);
    if (lq == 0) __hip_atomic_store(lsum + ((size_t)b * NCHK + n) * 1024 + ch, ((unsigned long long)__float_as_uint(carry) << 32) | (__float_as_uint(ptot) | 0x80000000u), __ATOMIC_RELAXED, __HIP_MEMORY_SCOPE_AGENT);
    unsigned long long v[8], vm = 0xbf800000ull; unsigned spin = 0;
#pragma unroll
    for (int i = 0; i < 8; ++i) v[i] = (8 * lq + i < n) ? __hip_atomic_load(lsum + ((size_t)b * NCHK + 8 * lq + i) * 1024 + ch, __ATOMIC_RELAXED, __HIP_MEMORY_SCOPE_AGENT) : 0xbf800000ull;
    if (lq == 0) vm = __hip_atomic_load(mslot + ch, __ATOMIC_RELAXED, __HIP_MEMORY_SCOPE_AGENT);
    for (;;) {
        bool ok = ((unsigned)vm >> 31) != 0u;
#pragma unroll
        for (int i = 0; i < 8; ++i) ok = ok && (((unsigned)v[i] >> 31) != 0u);
        if (__builtin_amdgcn_ballot_w64(!ok) == 0ull || ++spin > (1u << 18)) break;
        __builtin_amdgcn_s_sleep(8);
#pragma unroll
        for (int i = 0; i < 8; ++i) if (!((unsigned)v[i] >> 31)) v[i] = __hip_atomic_load(lsum + ((size_t)b * NCHK + 8 * lq + i) * 1024 + ch, __ATOMIC_RELAXED, __HIP_MEMORY_SCOPE_AGENT);
        if (!((unsigned)vm >> 31)) vm = __hip_atomic_load(mslot + ch, __ATOMIC_RELAXED, __HIP_MEMORY_SCOPE_AGENT);
    }
    float Pp = 1.f, Hp = 0.f;
#pragma unroll
    for (int i = 0; i < 8; ++i) { const float p = __uint_as_float((unsigned)v[i] & 0x7fffffffu), h = __uint_as_float((unsigned)(v[i] >> 32)); Hp = h + p * Hp; Pp *= p; }
    float cin = __shfl(__uint_as_float((unsigned)(vm >> 32)), li);
#pragma unroll
    for (int k = 0; k < 4; ++k) { const float pk = __shfl(Pp, li + 16 * k), hk = __shfl(Hp, li + 16 * k); cin = hk + pk * cin; }
#pragma unroll
    for (int m = 0; m < 8; ++m)
#pragma unroll
        for (int rg = 0; rg < 4; ++rg) XF[(16 * m + 4 * lq + rg) * 132 + cl] = ar[m][rg] + ai[m][rg] * cin;
    __syncthreads();
#pragma unroll
    for (int it = 0; it < 4; ++it) { const int t = tb + 32 * it; const f32x4 h0 = *(const LAS f32x4*)(XF + t * 132 + cg * 8), h1 = *(const LAS f32x4*)(XF + t * 132 + cg * 8 + 4); const u32x4 g = lgraw[it];
        u32x4 o; o.x = pk2(h0[0] * __uint_as_float(g[0] << 16), h0[1] * __uint_as_float(g[0] & 0xffff0000u)); o.y = pk2(h0[2] * __uint_as_float(g[1] << 16), h0[3] * __uint_as_float(g[1] & 0xffff0000u));
        o.z = pk2(h1[0] * __uint_as_float(g[2] << 16), h1[1] * __uint_as_float(g[2] & 0xffff0000u)); o.w = pk2(h1[2] * __uint_as_float(g[3] << 16), h1[3] * __uint_as_float(g[3] & 0xffff0000u));
        *(u32x4*)(WSP(bf16, WS_Y) + (row0 + t) * MIXW + ch0) = o; }
}
DI void meta_lru_item(const Ptrs& P, LAS unsigned char* lds, int item, int tid) {
    const int hh = item >> 3, cs = item & 7;
    LAS float* xcs = (LAS float*)lds;
    LAS float* prt = (LAS float*)(lds + 8192);
    LAS float* aus = (LAS float*)(lds + 12288);
    const float* mp = WSP(float, WS_METAP);
    __syncthreads();
    { const int c = tid & 127, jg = tid >> 7, chn = hh * 128 + c;
      for (int jj = 0; jj < 4; ++jj) { const int j = 4 * jg + jj; float s = P.conv_b[chn];
#pragma unroll
        for (int k = 0; k < 4; ++k) { const int js = j - 3 + k; if (js >= 0) s += P.conv_w[k * 1024 + chn] * mp[js * MPW + chn]; }
        xcs[j * 128 + c] = s; } }
    const int c = tid & 15, j = (tid >> 4) & 15, kh = tid >> 8, co = cs * 16 + c, ch = hh * 128 + co;
    float wr[32], wi[32];
#pragma unroll
    for (int i = 0; i < 32; ++i) { wr[i] = P.w_rg[(hh * 128 + 64 * kh + i) * 128 + co]; wi[i] = P.w_ig[(hh * 128 + 64 * kh + i) * 128 + co]; }
    __syncthreads();
    float rp = 0.f, ip = 0.f;
#pragma unroll
    for (int i = 0; i < 32; ++i) { const float xv = xcs[j * 128 + 64 * kh + i]; rp += xv * wr[i]; ip += xv * wi[i]; }
#pragma unroll
    for (int i = 0; i < 32; ++i) { wr[i] = P.w_rg[(hh * 128 + 64 * kh + 32 + i) * 128 + co]; wi[i] = P.w_ig[(hh * 128 + 64 * kh + 32 + i) * 128 + co]; }
#pragma unroll
    for (int i = 0; i < 32; ++i) { const float xv = xcs[j * 128 + 64 * kh + 32 + i]; rp += xv * wr[i]; ip += xv * wi[i]; }
    prt[((kh * 16 + j) * 16 + c) * 2] = rp; prt[((kh * 16 + j) * 16 + c) * 2 + 1] = ip;
    __syncthreads();
    if (tid < 256) { const float rz = prt[((0 * 16 + j) * 16 + c) * 2] + prt[((1 * 16 + j) * 16 + c) * 2] + P.b_rg[ch], iz = prt[((0 * 16 + j) * 16 + c) * 2 + 1] + prt[((1 * 16 + j) * 16 + c) * 2 + 1] + P.b_ig[ch];
        const float r = fsig(rz), ig = fsig(iz), la = -8.0f * r * WSP(float, WS_SP)[ch], av = __expf(la);
        aus[(j * 16 + c) * 2] = av; aus[(j * 16 + c) * 2 + 1] = beta_from(la, av) * ig * xcs[j * 128 + co]; }
    __syncthreads();
    if (tid < 16) { float h = 0.f; for (int jj = 0; jj < 16; ++jj) h = aus[(jj * 16 + tid) * 2] * h + aus[(jj * 16 + tid) * 2 + 1];
        __hip_atomic_store(WSP(unsigned long long, WS_MSLOT) + hh * 128 + cs * 16 + tid, ((unsigned long long)__float_as_uint(h) << 32) | 0xbf800000ull, __ATOMIC_RELAXED, __HIP_MEMORY_SCOPE_AGENT); }
}
DI void meta_kv_item(const Ptrs& P, LAS unsigned char* lds, int item, int tid) {
    const int h = item >> 3, ds = item & 7;
    LAS float* ks = (LAS float*)lds;
    LAS float* vs = (LAS float*)(lds + 4096);
    const float* mp = WSP(float, WS_METAP); const float lg = loggh(h);
    __syncthreads();
    { const int j = tid >> 5, i = tid & 31; const float x1 = mp[j * MPW + 1024 + h * 64 + i], x2 = mp[j * MPW + 1024 + h * 64 + 32 + i]; const f32x2 cs = WSP(f32x2, WS_ROT)[j * 32 + i];
      const float dec = __expf((float)(15 - j) * lg) * 0.125f; ks[j * 64 + 2 * i] = (x1 * cs.x - x2 * cs.y) * dec; ks[j * 64 + 2 * i + 1] = (x1 * cs.y + x2 * cs.x) * dec; }
    for (int idx = tid; idx < 16 * 128; idx += NT) vs[idx] = mp[(idx >> 7) * MPW + 1536 + h * 128 + (idx & 127)];
    __syncthreads();
    for (int o = tid; o < 8 * 128; o += NT) { const int d = ds * 8 + (o >> 7), e = o & 127; float s = 0.f;
#pragma unroll
        for (int j = 0; j < 16; ++j) s += ks[j * 64 + d] * vs[j * 128 + e];
        WSP(float, WS_KVM)[h * 8192 + d * 128 + e] = s; }
}
template <int NPIECE_LOG2, int NPER>
struct Stage { u32x4 v[NPER];
    DI void load(const bf16* src, size_t sstride, int tid) {
#pragma unroll
        for (int i = 0; i < NPER; ++i) { const int p = tid + NT * i, r = p >> NPIECE_LOG2, c = p & ((1 << NPIECE_LOG2) - 1); v[i] = __builtin_nontemporal_load((const u32x4*)(src + (size_t)r * sstride + c * 8)); } }
    DI void store(LAS unsigned char* dst, int dstride, int tid) const {
#pragma unroll
        for (int i = 0; i < NPER; ++i) { const int p = tid + NT * i, r = p >> NPIECE_LOG2, c = p & ((1 << NPIECE_LOG2) - 1); *(LAS u32x4*)(dst + r * dstride + c * 16) = v[i]; } }
};
DI void tile_map(int j, int& b, int& n, int& h) { const int l = (j & 255) >> 3; n = 8 * (j >> 8) + (j & 7); b = l >> 3; h = l & 7; }
struct KvRegs { Stage<3, 2> sk; Stage<4, 4> sv; };
DI void kv_load(const Ptrs& P, int j, KvRegs& R, int tid) {
    int b, n, h; tile_map(j, b, n, h); const size_t row0 = (size_t)b * SEQ + (size_t)n * CHK;
    R.sk.load(WSP(bf16, WS_KK) + row0 * 512 + h * 64, 512, tid); R.sv.load(WSP(bf16, WS_V) + row0 * 1024 + h * 128, 1024, tid);
}
DI void kv_tile(const Ptrs& P, LAS unsigned char* lds, int j, int jnext, KvRegs& R, int tid) {
    int b, n, h; tile_map(j, b, n, h);
    LAS unsigned char* KD = lds;
    LAS unsigned char* VV = lds + 18432;
    const int wave = __builtin_amdgcn_readfirstlane(tid >> 6), lane = tid & 63, li = lane & 15, lg4 = lane >> 4, q4 = li >> 2, p4 = li & 3;
    const size_t row0 = (size_t)b * SEQ + (size_t)n * CHK; const float lg = loggh(h);
    __syncthreads();
#pragma unroll
    for (int it = 0; it < 2; ++it) { const int p = tid + NT * it, c = p >> 3, c8 = p & 7;
        const u32x4 w = R.sk.v[it]; const float dec = __expf((float)(127 - c) * lg); u32x4 o;
#pragma unroll
        for (int j = 0; j < 4; ++j) o[j] = pk2(__uint_as_float(w[j] << 16) * dec, __uint_as_float(w[j] & 0xffff0000u) * dec);
        *(LAS u32x4*)(KD + c * 144 + c8 * 16) = o; }
    R.sv.store(VV, 272, tid);
    __syncthreads();
    if (jnext >= 0) kv_load(P, jnext, R, tid);
    f32x4 acc[4];
#pragma unroll
    for (int db = 0; db < 4; ++db) acc[db] = (f32x4){0.f, 0.f, 0.f, 0.f};
#pragma unroll
    for (int cs = 0; cs < 4; ++cs) {
        const LAS unsigned char* vb = VV + (32 * cs + 8 * lg4 + q4) * 272 + (16 * wave + 4 * p4) * 2;
        const bf16x8 bf = cat8(tr_read(vb), tr_read(vb + 4 * 272));
#pragma unroll
        for (int db = 0; db < 4; ++db) { const LAS unsigned char* kb = KD + (32 * cs + 8 * lg4 + q4) * 144 + (16 * db + 4 * p4) * 2;
            const bf16x8 af = cat8(tr_read(kb), tr_read(kb + 4 * 144)); acc[db] = MFMA16(af, bf, acc[db]); }
    }
    float* o = P.out + (((size_t)b * NCHK + n) * 8 + h) * 8192;
#pragma unroll
    for (int db = 0; db < 4; ++db)
#pragma unroll
        for (int rg = 0; rg < 4; ++rg) o[(16 * db + 4 * lg4 + rg) * 128 + 16 * wave + li] = acc[db][rg];
}
DI void p3_scans(const Ptrs& P, int flags, int tid) {
    const int gt = blockIdx.x * NT + tid, GT = gridDim.x * NT;
    if (flags & 2) for (int idx = gt; idx < BATCH * 8 * 4096; idx += GT) {
        const int bh = idx >> 12, de = (idx & 4095) * 2, b = bh >> 3, h = bh & 7; const float G = __expf(128.0f * loggh(h));
        f32x2 st = *(const f32x2*)(WSP(float, WS_KVM) + h * 8192 + de); f32x2 kv[NCHK];
#pragma unroll
        for (int n = 0; n < NCHK; ++n) kv[n] = __builtin_nontemporal_load((const f32x2*)(P.out + (((size_t)b * NCHK + n) * 8 + h) * 8192 + de));
#pragma unroll
        for (int n = 0; n < NCHK; ++n) { *(unsigned*)(WSP(bf16, WS_RPREV) + (((size_t)b * NCHK + n) * 8 + h) * 8192 + de) = pk2(st.x, st.y); st = st * G + kv[n]; } }
}
struct RetRegs { Stage<3, 2> sq, sk; Stage<4, 4> sv; Stage<4, 2> sr; u32x4 rg[4]; };
DI void ret_load(const Ptrs& P, int j, RetRegs& R, int tid) {
    int b, n, h; tile_map(j, b, n, h); const size_t row0 = (size_t)b * SEQ + (size_t)n * CHK; const int tb = tid >> 4, cg = tid & 15;
    R.sq.load(WSP(bf16, WS_Q) + row0 * 512 + h * 64, 512, tid); R.sk.load(WSP(bf16, WS_KK) + row0 * 512 + h * 64, 512, tid);
    R.sv.load(WSP(bf16, WS_V) + row0 * 1024 + h * 128, 1024, tid); R.sr.load(WSP(bf16, WS_RPREV) + (((size_t)b * NCHK + n) * 8 + h) * 8192, 128, tid);
#pragma unroll
    for (int it = 0; it < 4; ++it) R.rg[it] = __builtin_nontemporal_load((const u32x4*)(WSP(bf16, WS_RG) + (row0 + tb + 32 * it) * 1024 + h * 128 + cg * 8));
}
DI void ret_tile(const Ptrs& P, LAS unsigned char* lds, int j, int jnext, RetRegs& R, int tid) {
    int b, n, h; tile_map(j, b, n, h);
    LAS unsigned char* QS = lds;
    LAS unsigned char* KS = lds + 18432;
    LAS unsigned char* VS = lds + 36864;
    LAS unsigned char* RS = lds + 71680;
    LAS unsigned char* SS = lds + 89088;
    const int wave = __builtin_amdgcn_readfirstlane(tid >> 6), lane = tid & 63, li = lane & 15, lg4 = lane >> 4, q4 = li >> 2, p4 = li & 3;
    const size_t row0 = (size_t)b * SEQ + (size_t)n * CHK; const float lg = loggh(h);
    float gnv[8]; u32x4 rgraw[4]; const int tb = tid >> 4, cg = tid & 15;
#pragma unroll
    for (int eb = 0; eb < 8; ++eb) gnv[eb] = P.rng[h * 128 + 16 * eb + li];
    __syncthreads();
    R.sq.store(QS, 144, tid); R.sk.store(KS, 144, tid); R.sv.store(VS, 272, tid); R.sr.store(RS, 272, tid);
#pragma unroll
    for (int it = 0; it < 4; ++it) rgraw[it] = R.rg[it];
    __syncthreads();
    if (jnext >= 0) ret_load(P, jnext, R, tid);
    bf16x8 aq[2];
#pragma unroll
    for (int ks = 0; ks < 2; ++ks) aq[ks] = *(const LAS bf16x8*)(QS + (16 * wave + li) * 144 + (32 * ks + 8 * lg4) * 2);
    const int mbmax = wave | 1;
    for (int mb = 0; mb <= mbmax; mb += 2) {
        bf16x8 bk[2][2];
#pragma unroll
        for (int u = 0; u < 2; ++u)
#pragma unroll
            for (int ks = 0; ks < 2; ++ks) bk[u][ks] = *(const LAS bf16x8*)(KS + (16 * (mb + u) + li) * 144 + (32 * ks + 8 * lg4) * 2);
        f32x4 s2[2];
#pragma unroll
        for (int u = 0; u < 2; ++u) { s2[u] = (f32x4){0.f, 0.f, 0.f, 0.f}; s2[u] = MFMA16(aq[0], bk[u][0], s2[u]); }
#pragma unroll
        for (int u = 0; u < 2; ++u) s2[u] = MFMA16(aq[1], bk[u][1], s2[u]);
#pragma unroll
        for (int u = 0; u < 2; ++u)
#pragma unroll
            for (int rg = 0; rg < 4; ++rg) { const int c = 16 * wave + 4 * lg4 + rg, m = 16 * (mb + u) + li, dd = c - m; const float e = __expf((float)(dd > 0 ? dd : 0) * lg);
                const float w = dd >= 0 ? s2[u][rg] * e : 0.f; *(LAS bf16*)(SS + c * 272 + m * 2) = f2bf(w); }
    }
    __syncthreads();
    f32x4 oin[8], ox[8];
#pragma unroll
    for (int eb = 0; eb < 8; ++eb) { oin[eb] = (f32x4){0.f, 0.f, 0.f, 0.f}; ox[eb] = (f32x4){0.f, 0.f, 0.f, 0.f}; }
    const int msmax = wave >> 1;
    for (int ms = 0; ms <= msmax; ++ms) {
        const bf16x8 as = *(const LAS bf16x8*)(SS + (16 * wave + li) * 272 + (32 * ms + 8 * lg4) * 2);
        s16x4 tv[8][2];
#pragma unroll
        for (int eb = 0; eb < 8; ++eb) { const LAS unsigned char* vb = VS + (32 * ms + 8 * lg4 + q4) * 272 + (16 * eb + 4 * p4) * 2; tv[eb][0] = tr_read(vb); tv[eb][1] = tr_read(vb + 4 * 272); }
#pragma unroll
        for (int eb = 0; eb < 8; ++eb) oin[eb] = MFMA16(as, cat8(tv[eb][0], tv[eb][1]), oin[eb]);
    }
#pragma unroll
    for (int ks = 0; ks < 2; ++ks)
#pragma unroll
        for (int eb = 0; eb < 8; ++eb) { const LAS unsigned char* rb = RS + (32 * ks + 8 * lg4 + q4) * 272 + (16 * eb + 4 * p4) * 2;
            ox[eb] = MFMA16(aq[ks], cat8(tr_read(rb), tr_read(rb + 4 * 272)), ox[eb]); }
    __syncthreads();
    LAS float* OF = (LAS float*)lds;
#pragma unroll
    for (int rg = 0; rg < 4; ++rg) {
        const int c = 16 * wave + 4 * lg4 + rg; const float dq = __expf((float)(c + 1) * lg); float o[8], s = 0.f;
#pragma unroll
        for (int eb = 0; eb < 8; ++eb) { o[eb] = oin[eb][rg] + dq * ox[eb][rg]; s += o[eb]; }
        s += __shfl_xor(s, 1); s += __shfl_xor(s, 2); s += __shfl_xor(s, 4); s += __shfl_xor(s, 8);
        const float mu = s * (1.0f / 128.0f); float q = 0.f;
#pragma unroll
        for (int eb = 0; eb < 8; ++eb) { o[eb] -= mu; q += o[eb] * o[eb]; }
        q += __shfl_xor(q, 1); q += __shfl_xor(q, 2); q += __shfl_xor(q, 4); q += __shfl_xor(q, 8);
        const float rs = 1.0f / sqrtf(q * (1.0f / 128.0f) + EPSN);
#pragma unroll
        for (int eb = 0; eb < 8; ++eb) OF[c * 132 + 16 * eb + li] = o[eb] * rs * gnv[eb];
    }
    __syncthreads();
#pragma unroll
    for (int it = 0; it < 4; ++it) { const int t = tb + 32 * it; const f32x4 h0 = *(const LAS f32x4*)(OF + t * 132 + cg * 8), h1 = *(const LAS f32x4*)(OF + t * 132 + cg * 8 + 4); const u32x4 g = rgraw[it];
        u32x4 o; o.x = pk2(h0[0] * __uint_as_float(g[0] << 16), h0[1] * __uint_as_float(g[0] & 0xffff0000u)); o.y = pk2(h0[2] * __uint_as_float(g[1] << 16), h0[3] * __uint_as_float(g[1] & 0xffff0000u));
        o.z = pk2(h1[0] * __uint_as_float(g[2] << 16), h1[1] * __uint_as_float(g[2] & 0xffff0000u)); o.w = pk2(h1[2] * __uint_as_float(g[3] << 16), h1[3] * __uint_as_float(g[3] & 0xffff0000u));
        *(u32x4*)(WSP(bf16, WS_Y) + (row0 + t) * MIXW + 1024 + h * 128 + cg * 8) = o; }
}
#define XB_TMO      128
#define XB_XCNT(j)  (256  + 64 * (j))
#define XB_XSUB(j)  (1280 + 64 * (j))
#define XB_XGEN(j)  (2304 + 64 * (j))
#define XB_TOP      3328
#define XB_TOPGEN   3392
#define XCD_BAR_WORDS 3456
#define XB_SPIN_CAP (1u << 18)

__device__ __forceinline__ unsigned xb_ld(unsigned* p)              { return __hip_atomic_load(p, __ATOMIC_RELAXED, __HIP_MEMORY_SCOPE_AGENT); }
__device__ __forceinline__ unsigned xb_add(unsigned* p, unsigned v) { return __hip_atomic_fetch_add(p, v, __ATOMIC_RELAXED, __HIP_MEMORY_SCOPE_AGENT); }
__device__ __forceinline__ unsigned xb_xcc_id() { return (unsigned)__builtin_amdgcn_s_getreg((3 << 11) | 20) & 0xFu; }
#define XB_SPIN(cond, bar) do { unsigned _sp = 0; while (cond) { __builtin_amdgcn_s_sleep(6); \
    if ((++_sp & 255u) == 0u) { if (xb_ld(&(bar)[XB_TMO])) break; if (_sp > XB_SPIN_CAP) { atomicAdd(&(bar)[XB_TMO], 1u); break; } } } } while (0)

struct XcdBarrier {
    unsigned* bar; unsigned x;
    volatile LAS unsigned* st;
};

__device__ __forceinline__ XcdBarrier xcd_barrier_post(unsigned* bar, volatile LAS unsigned* st) {
    XcdBarrier b; b.bar = bar; b.x = xb_xcc_id(); b.st = st;
    if (threadIdx.x == 0) (void)xb_add(&bar[XB_XCNT(b.x)], 1u);
    return b;
}
__device__ __forceinline__ void xcd_barrier_complete(unsigned* bar, unsigned x, unsigned& nloc, unsigned& nx) {
    const unsigned G = gridDim.x * gridDim.y * gridDim.z;
    unsigned sum, cnt, mine, sp = 0u;
    for (;;) {
        sum = 0u; cnt = 0u; mine = 0u;
#pragma unroll
        for (unsigned j = 0; j < 16; ++j) { const unsigned c = xb_ld(&bar[XB_XCNT(j)]); sum += c; cnt += (c > 0u) ? 1u : 0u; mine = (j == x) ? c : mine; }
        if (sum == G) break;
        __builtin_amdgcn_s_sleep(1);
        if ((++sp & 255u) == 0u) { if (xb_ld(&bar[XB_TMO])) break; if (sp > XB_SPIN_CAP) { atomicAdd(&bar[XB_TMO], 1u); break; } }
    }
    nloc = mine > 0u ? mine : 1u; nx = cnt > 0u ? cnt : 1u;
}

__device__ __forceinline__ void xcd_barrier(const XcdBarrier& b) {
    asm volatile("s_waitcnt vmcnt(0)" ::: "memory");
    __syncthreads();
    if (threadIdx.x == 0) {
        unsigned* bar = b.bar;
        __builtin_amdgcn_s_waitcnt(0);
        unsigned nloc = b.st[0], nx = b.st[1];
        if (nloc == 0u) { xcd_barrier_complete(bar, b.x, nloc, nx); b.st[0] = nloc; b.st[1] = nx; }
        const unsigned old = xb_add(&bar[XB_XSUB(b.x)], 1u);
        const unsigned gen = old / nloc;
        if (old + 1u == (gen + 1u) * nloc) {
            __builtin_amdgcn_fence(__ATOMIC_RELEASE, "agent");
            asm volatile("s_waitcnt vmcnt(0)" ::: "memory");
            const unsigned og = xb_add(&bar[XB_TOP], 1u);
            const unsigned tg = og / nx;
            if (og + 1u == (tg + 1u) * nx) xb_add(&bar[XB_TOPGEN], 1u);
            else XB_SPIN(xb_ld(&bar[XB_TOPGEN]) == tg, bar);
            __builtin_amdgcn_fence(__ATOMIC_ACQUIRE, "agent");
            xb_add(&bar[XB_XGEN(b.x)], 1u);
            asm volatile("s_waitcnt vmcnt(0)" ::: "memory");
        } else {
            XB_SPIN(xb_ld(&bar[XB_XGEN(b.x)]) == gen, bar);
            __builtin_amdgcn_fence(__ATOMIC_ACQUIRE, "agent");
            asm volatile("s_waitcnt vmcnt(0)" ::: "memory");
        }
    }
    __syncthreads();
}
#ifdef NO_LRU
#define lru_tile(...) ((void)0)
#endif
#ifdef NO_RET
#define ret_tile(...) ((void)0)
#endif
#ifdef NO_KV
#define kv_tile(...) ((void)0)
#endif
#ifdef NO_P3
#define p3_scans(...) ((void)0)
#endif
#ifdef NO_P0
#define p0_prologue(...) ((void)0)
#endif
#ifndef OPT_P0
#define OPT_P0 1
#endif
#ifndef OPT_P1
#define OPT_P1 1
#endif
#ifndef OPT_LRU
#define OPT_LRU 1
#endif
#ifndef OPT_RET
#define OPT_RET 1
#endif
#ifndef OPT_P5
#define OPT_P5 1
#endif
#ifndef FUSED
#define FUSED 1
#endif
#ifndef PROBE_FLAGS
#define PROBE_FLAGS 3
#endif
#ifndef PROBE_P0
#define PROBE_P0 0
#endif
#ifndef PROBE_P1
#define PROBE_P1 0
#endif
#ifndef PROBE_P24
#define PROBE_P24 0
#endif
#ifndef PROBE_P3
#define PROBE_P3 0
#endif
#ifndef PROBE_P5
#define PROBE_P5 0
#endif
struct Args { Ptrs P; int ph_lo, ph_hi, flags, pad; };
__global__ void __launch_bounds__(NT, 2) mega(Args a) {
    extern __shared__ __attribute__((aligned(16))) unsigned char lds_raw[];
    cg::grid_group grid = cg::this_grid();
    LAS unsigned char* lds = (LAS unsigned char*)lds_raw;
    const Ptrs& P = a.P; const int tid = threadIdx.x, G = gridDim.x, lo = a.ph_lo, hi = a.ph_hi, flags = a.flags;
    volatile LAS unsigned* bst = (volatile LAS unsigned*)(lds + 131072 + 256);
    if (tid < 2) bst[tid] = 0u;
    __syncthreads();
    const XcdBarrier bar = xcd_barrier_post(WSP(unsigned, WS_BAR), bst);
    if (a.pad == 0x7fffffff) grid.sync();
#define IN(k) (lo <= (k) && (k) < hi)
#define SEAM(k) do { if (IN(k) && IN((k) + 1)) xcd_barrier(bar); } while (0)
#ifdef PROBE_SYNC
    for (int i = 0; i < 10; ++i) xcd_barrier(bar);
#endif
    if (IN(0)) { p0_prologue(P, lds, tid); if (PROBE_P0) { xcd_barrier(bar); p0_prologue(P, lds, tid); } }
    SEAM(0);
    if (IN(1)) {
        pg8::Gemm g{WSP(bf16, WS_HB), WSP(bf16, WS_W1T), MROWS, INW, DM}; pg8::StaticOrder S; S.init(MROWS, INW, G, (int)blockIdx.x);
        pg8::Epi1 E{WSP(float, WS_RSTD), (const pg8::f32x2e*)WSP(f32x2, WS_ROT), WSP(bf16, WS_LX), WSP(bf16, WS_LG), WSP(bf16, WS_Q), WSP(bf16, WS_KK), WSP(bf16, WS_V), WSP(bf16, WS_RG)};
        pg8::gemm_phase<pg8::Epi1, pg8::StaticOrder, true, true>(lds, g, S, E);
        if (PROBE_P1) { xcd_barrier(bar); pg8::gemm_phase<pg8::Epi1, pg8::StaticOrder, true, true>(lds, g, S, E); }
    }
    SEAM(1);
    if (IN(2)) {
        for (int rep = 0; rep < (PROBE_P24 ? 2 : 1); ++rep) { const int flags = rep ? PROBE_P24 : a.flags; if (rep) xcd_barrier(bar);
        if ((flags & 1) && (int)blockIdx.x < 64) meta_lru_item(P, lds, blockIdx.x, tid);
        if (flags & 1) { LruConst LC; LC.hh = -1;
            for (int it = blockIdx.x; it < 1024; it += G) { int b, n, hh; tile_map(it, b, n, hh); lru_tile(P, lds, b, n, hh, tid, LC); } }
        if (flags & 2) { if ((int)blockIdx.x >= 64 && (int)blockIdx.x < 128) meta_kv_item(P, lds, blockIdx.x - 64, tid);
            KvRegs KR; int it = blockIdx.x; if (it < 1024) kv_load(P, it, KR, tid);
            for (; it < 1024; it += G) kv_tile(P, lds, it, it + G < 1024 ? it + G : -1, KR, tid); }
        }
    }
    SEAM(2);
    if (IN(3)) { p3_scans(P, flags, tid); if (PROBE_P3) { xcd_barrier(bar); p3_scans(P, flags, tid); } }
    SEAM(3);
    if (IN(4)) {
        for (int rep = 0; rep < (PROBE_P24 ? 2 : 1); ++rep) { const int flags = rep ? PROBE_P24 : a.flags; if (rep) xcd_barrier(bar);
        if (flags & 2) { RetRegs RR; if ((int)blockIdx.x < 1024) ret_load(P, blockIdx.x, RR, tid);
            for (int it = blockIdx.x; it < 1024; it += G) ret_tile(P, lds, it, it + G < 1024 ? it + G : -1, RR, tid); } }
    }
    SEAM(4);
    if (IN(5)) {
        __syncthreads();
        pg8::Gemm g{WSP(bf16, WS_Y), WSP(bf16, WS_W2T), MROWS, DM, MIXW}; pg8::StaticOrder S; S.init(MROWS, DM, G, (int)blockIdx.x);
        if (G == 256) { pg8::Epi5F E{P.x, P.out, P.fgain, WSP(unsigned, WS_XBUF), WSP(unsigned, WS_PCNT)};
            pg8::gemm_phase<pg8::Epi5F, pg8::StaticOrder, false, true>(lds, g, S, E); }
        else { pg8::Epi5 E{P.x, P.out}; pg8::gemm_phase<pg8::Epi5, pg8::StaticOrder, false, true>(lds, g, S, E); }
    }
    if (G != 256) {
    SEAM(5);
    if (IN(6)) { const int gw = blockIdx.x * 8 + (tid >> 6), NGW = G * 8; for (int m = gw; m < MROWS; m += NGW) final_norm_row(P.out + (size_t)m * DM, P.fgain, tid & 63); }
    }
#undef IN
#undef SEAM
}

static int g_grid = 0;
static void launch_mega(const Ptrs& P, int lo, int hi, int flags, hipStream_t stream) {
    Args a{}; a.P = P; a.ph_lo = lo; a.ph_hi = hi; a.flags = flags; a.pad = 0;
    void* args[] = {&a};
    (void)hipMemsetAsync(P.ws + WS_BAR, 0, WS_ZERO_BYTES, stream);
    hipError_t e = hipLaunchCooperativeKernel((const void*)mega, dim3(g_grid), dim3(NT), args, LDS_BYTES, stream);
    if (e != hipSuccess) fprintf(stderr, "cooperative launch failed: %s (grid %d)\n", hipGetErrorString(e), g_grid);
}
extern "C" void kernel_launch(void* const* d_in, const int* in_sizes, int n_in, void* d_out, int out_size, void* d_ws, size_t ws_size, hipStream_t stream) {
    if (g_grid == 0) {
        int dev = 0, cus = 0, per_cu = 0;
        hipGetDevice(&dev); hipDeviceGetAttribute(&cus, hipDeviceAttributeMultiprocessorCount, dev);
        hipFuncSetAttribute((const void*)mega, hipFuncAttributeMaxDynamicSharedMemorySize, LDS_BYTES);
        hipFuncSetAttribute((const void*)n_lru, hipFuncAttributeMaxDynamicSharedMemorySize, (2 * 128 * 128 + 128) * 4);
        hipOccupancyMaxActiveBlocksPerMultiprocessor(&per_cu, (const void*)mega, NT, LDS_BYTES);
        if (per_cu < 1) { fprintf(stderr, "occupancy query: %d blocks per CU\n", per_cu); per_cu = 1; }
        g_grid = cus * 1;
        if (n_in != 14 || ws_size < WS_END) fprintf(stderr, "unexpected n_in %d / ws_size %zu\n", n_in, ws_size);
    }
    Ptrs P{};
    P.x = (const float*)d_in[0]; P.meta = (const float*)d_in[1]; P.ngain = (const float*)d_in[2]; P.w_in = (const float*)d_in[3]; P.conv_w = (const float*)d_in[4]; P.conv_b = (const float*)d_in[5];
    P.w_rg = (const float*)d_in[6]; P.b_rg = (const float*)d_in[7]; P.w_ig = (const float*)d_in[8]; P.b_ig = (const float*)d_in[9]; P.lam = (const float*)d_in[10]; P.rng = (const float*)d_in[11];
    P.w_out = (const float*)d_in[12]; P.fgain = (const float*)d_in[13]; P.out = (float*)d_out; P.ws = (unsigned char*)d_ws;
#if FUSED
#ifdef PROBE_PREFIX
    launch_mega(P, 0, PROBE_PREFIX, PROBE_FLAGS, stream);
#endif
    launch_mega(P, 0, 7, 3, stream);
#ifdef PROBE_TWICE
    launch_mega(P, 0, 7, 3, stream);
#endif
#else
    if (OPT_P0) launch_mega(P, 0, 1, 3, stream);
    else { n0_rows<<<MROWS * 64 / 256, 256, 0, stream>>>(P); n0_misc<<<(TPOS * 32 + 1024 + 255) / 256, 256, 0, stream>>>(P); n0_w1t<<<INW * DM / 256, 256, 0, stream>>>(P);
           n0_w2t<<<DM * MIXW / 256, 256, 0, stream>>>(P); n0_wgt<<<2 * 8 * 128 * 128 / 256, 256, 0, stream>>>(P); n0_meta<<<NMETA * MPW / 256, 256, 0, stream>>>(P); }
    if (OPT_P1) launch_mega(P, 1, 2, 3, stream);
    else n1_gemm1<<<(unsigned)((size_t)MROWS * (INW / 2) / 256), 256, 0, stream>>>(P);
    if (OPT_LRU || OPT_RET) launch_mega(P, 2, 5, (OPT_LRU ? 1 : 0) | (OPT_RET ? 2 : 0), stream);
    if (!OPT_LRU) n_lru<<<BATCH * 8, 128, (2 * 128 * 128 + 128) * 4, stream>>>(P);
    if (!OPT_RET) n_ret<<<BATCH * 8, 128, 0, stream>>>(P);
    if (OPT_P5) launch_mega(P, 5, 7, 3, stream);
    else { n5_gemm2<<<MROWS * (DM / 2) / 256, 256, 0, stream>>>(P); n6_norm<<<MROWS * 64 / 256, 256, 0, stream>>>(P); }
#endif
}
```

```cpp
#include <hip/hip_runtime.h>
#include <hip/hip_cooperative_groups.h>
#include <cstdio>
#include <cstdint>
namespace cg = cooperative_groups;
#define DI __device__ __forceinline__

namespace pg8 {
#define PG8_LAS __attribute__((address_space(3)))
typedef unsigned short bf16_t;
typedef short bf16x8 __attribute__((ext_vector_type(8)));
typedef float f32x4 __attribute__((ext_vector_type(4)));
typedef unsigned u32x4 __attribute__((ext_vector_type(4)));
constexpr int BM = 256, BK = 64, HALF = 128, HTB = HALF * BK * 2  , STAGE_BYTES = 8 * HTB, NXCD = 8, WGM = 8;

__host__ __device__ __forceinline__ int lds_byte(int r, int c) { const int st = (r >> 4) * 2 + (c >> 5), rr = r & 15, cc = c & 31, ob = rr * 64 + cc * 2; return st * 1024 + (ob ^ (((ob >> 9) & 1) << 5)); }
__host__ __device__ __forceinline__ void stage_rc(int b, int& R, int& C) { const int st = b / 1024, sb = b % 1024, swz = sb ^ (((sb >> 9) & 1) << 5); R = (st >> 1) * 16 + swz / 64; C = (st & 1) * 32 + (swz % 64) / 2; }
__host__ __device__ __forceinline__ int perm32(int rho) { const int n = rho >> 4, i = rho & 15; return 8 * (i >> 2) + 4 * n + (i & 3); }

struct Unit { int pm, pn; };
struct Gemm { const bf16_t* A; const bf16_t* Bt; int M, N, K; };

struct StaticOrder {
    int nM, nN, nwg, G, c;
    __host__ __device__ void init(int M, int N, int G_, int c_) { nM = M / BM; nN = N / BM; nwg = nM * nN; G = G_; c = c_; }
    __host__ __device__ bool next(int i, Unit& u) const {
        const long L = (long)i * G + c; if (L >= nwg) return false;
        int wgid = (int)L; { const int q = nwg / NXCD, r = nwg % NXCD, xcd = wgid % NXCD, off = wgid / NXCD; wgid = (xcd < r ? xcd * (q + 1) : r * (q + 1) + (xcd - r) * q) + off; }
        const int nig = WGM * nN, gid = wgid / nig, fm = gid * WGM, gsz = (nM - fm) < WGM ? (nM - fm) : WGM;
        u.pm = fm + ((wgid % nig) % gsz); u.pn = (wgid % nig) / gsz; return true;
    }
    __device__ __forceinline__ void a_ready(const Unit&) const {}
    __device__ __forceinline__ void done(const Unit&) const {}
};
__device__ __forceinline__ unsigned cvt_pk_bf16(float lo, float hi) { unsigned r; asm volatile("v_cvt_pk_bf16_f32 %0, %1, %2" : "=v"(r) : "v"(lo), "v"(hi)); return r; }
typedef float f32x2e __attribute__((ext_vector_type(2)));
DI float silu_f(float x) { return x * __builtin_amdgcn_rcpf(1.f + __expf(-x)); }
struct Epi1 {
    static constexpr bool PERM = true, AFTER_DRAIN = false, HAS_INIT = false;
    const float* rstd; const f32x2e* rot; bf16_t *LX, *LG, *Q, *KK, *V, *RG;
    __device__ __forceinline__ void operator()(const f32x4 (&acc)[2][2][4][2], const Unit& u, int wr, int wc, int fr, int fq) const {
        const int row0 = u.pm * BM + wr * 64 + fr; const int pn = u.pn;
        bf16_t* dst; int ldc, cb, mode; float sc = 1.f;
        if (pn < 4) { dst = LX; ldc = 1024; cb = pn * 256; mode = 0; }
        else if (pn < 8) { dst = LG; ldc = 1024; cb = pn * 256 - 1024; mode = 1; }
        else if (pn < 10) { dst = Q; ldc = 512; cb = pn * 256 - 2048; mode = 2; }
        else if (pn < 12) { dst = KK; ldc = 512; cb = pn * 256 - 2560; mode = 2; sc = 0.125f; }
        else if (pn < 16) { dst = V; ldc = 1024; cb = pn * 256 - 3072; mode = 0; }
        else { dst = RG; ldc = 1024; cb = pn * 256 - 4096; mode = 1; }
        const int col0 = cb + wc * 32 + 8 * fq;
        float rsv[2][4];
#pragma unroll
        for (int ai = 0; ai < 2; ++ai)
#pragma unroll
            for (int m = 0; m < 4; ++m) rsv[ai][m] = rstd[row0 + ai * HALF + m * 16] * sc;
        f32x2e csv[4][4];
#pragma unroll
        for (int ai = 0; ai < 2; ++ai) {
        if (mode == 2) {
#pragma unroll
            for (int m = 0; m < 4; ++m) { const int r = row0 + ai * HALF + m * 16; const f32x2e* cs = rot + (16 + (r & 4095)) * 32 + ((col0 & 63) >> 1);
#pragma unroll
                for (int j = 0; j < 4; ++j) csv[m][j] = cs[j]; }
        }
#pragma unroll
            for (int m = 0; m < 4; ++m) {
                const int r = row0 + ai * HALF + m * 16; const float rs = rsv[ai][m];
                bf16_t* rowp = dst + (size_t)r * ldc + col0;
#pragma unroll
                for (int bj = 0; bj < 2; ++bj) {
                    f32x4 v0 = acc[ai][bj][m][0] * rs, v1 = acc[ai][bj][m][1] * rs;
                    if (mode == 1) {
#pragma unroll
                        for (int j = 0; j < 4; ++j) { v0[j] = silu_f(v0[j]); v1[j] = silu_f(v1[j]); }
                    } else if (mode == 2) {
                        const f32x2e c0 = csv[m][0], c1 = csv[m][1], c2 = csv[m][2], c3 = csv[m][3];
                        float a, b;
                        a = v0[0]; b = v0[1]; v0[0] = a * c0.x - b * c0.y; v0[1] = a * c0.y + b * c0.x;
                        a = v0[2]; b = v0[3]; v0[2] = a * c1.x - b * c1.y; v0[3] = a * c1.y + b * c1.x;
                        a = v1[0]; b = v1[1]; v1[0] = a * c2.x - b * c2.y; v1[1] = a * c2.y + b * c2.x;
                        a = v1[2]; b = v1[3]; v1[2] = a * c3.x - b * c3.y; v1[3] = a * c3.y + b * c3.x;
                    }
                    u32x4 w; w.x = cvt_pk_bf16(v0[0], v0[1]); w.y = cvt_pk_bf16(v0[2], v0[3]); w.z = cvt_pk_bf16(v1[0], v1[1]); w.w = cvt_pk_bf16(v1[2], v1[3]);
                    *(u32x4*)(rowp + bj * HALF) = w;
                }
            }
        }
    }
};
struct Epi5 {
    static constexpr bool PERM = false, AFTER_DRAIN = false, HAS_INIT = false;
    const float* x; float* out;
    __device__ __forceinline__ void operator()(const f32x4 (&acc)[2][2][4][2], const Unit& u, int wr, int wc, int fr, int fq) const {
        const int row0 = u.pm * BM + wr * 64 + fr, col0 = u.pn * BM + wc * 32 + 4 * fq;
#pragma unroll
        for (int ai = 0; ai < 2; ++ai) {
            f32x4 xv[4][2][2];
#pragma unroll
            for (int m = 0; m < 4; ++m) { const size_t off = (size_t)(row0 + ai * HALF + m * 16) * 1024 + col0;
#pragma unroll
                for (int bj = 0; bj < 2; ++bj)
#pragma unroll
                    for (int n = 0; n < 2; ++n) xv[m][bj][n] = *(const f32x4*)(x + off + bj * HALF + n * 16); }
#pragma unroll
            for (int m = 0; m < 4; ++m) { const size_t off = (size_t)(row0 + ai * HALF + m * 16) * 1024 + col0;
#pragma unroll
                for (int bj = 0; bj < 2; ++bj)
#pragma unroll
                    for (int n = 0; n < 2; ++n) *(f32x4*)(out + off + bj * HALF + n * 16) = acc[ai][bj][m][n] + xv[m][bj][n]; }
        }
    }
};

struct Epi5F {
    static constexpr bool PERM = false, AFTER_DRAIN = true, HAS_INIT = true;
    const float* x; float* out; const float* fg; unsigned* xbuf; unsigned* cnt;
    __device__ __forceinline__ void init(f32x4 (&acc)[2][2][4][2], const Unit& u, int wr, int wc, int fr, int fq) const {
        const int row0 = u.pm * BM + wr * 64 + fr, col0 = u.pn * BM + wc * 32 + 4 * fq;
#pragma unroll
        for (int ai = 0; ai < 2; ++ai)
#pragma unroll
            for (int m = 0; m < 4; ++m) { const size_t off = (size_t)(row0 + ai * HALF + m * 16) * 1024 + col0;
#pragma unroll
                for (int bj = 0; bj < 2; ++bj)
#pragma unroll
                    for (int n = 0; n < 2; ++n) acc[ai][bj][m][n] = __builtin_nontemporal_load((const f32x4*)(x + off + bj * HALF + n * 16)); }
    }
    __device__ __forceinline__ void fused(f32x4 (&acc)[2][2][4][2], const Unit& u, int wr, int wc, int fr, int fq, PG8_LAS unsigned char* lds, int wid, int lane) const {
        PG8_LAS float* Pp = (PG8_LAS float*)lds;
        PG8_LAS float* S = (PG8_LAS float*)(lds + 4096);
        const int row0 = u.pm * BM + wr * 64 + fr, col0 = u.pn * BM + wc * 32 + 4 * fq;
#pragma unroll
        for (int ai = 0; ai < 2; ++ai)
#pragma unroll
            for (int m = 0; m < 4; ++m) { float s = 0.f;
#pragma unroll
                for (int bj = 0; bj < 2; ++bj)
#pragma unroll
                    for (int n = 0; n < 2; ++n) { const f32x4 v = acc[ai][bj][m][n]; s += (v[0] * v[0] + v[1] * v[1]) + (v[2] * v[2] + v[3] * v[3]); }
                s += __shfl_xor(s, 16); s += __shfl_xor(s, 32);
                if (fq == 0) Pp[(ai * HALF + wr * 64 + m * 16 + fr) * 4 + wc] = s; }
        asm volatile("s_waitcnt lgkmcnt(0)" ::: "memory"); __builtin_amdgcn_s_barrier(); asm volatile("" ::: "memory");
        const int row = wid * 32 + (lane & 31);
        if (lane < 32) {
            const float t = (Pp[row * 4 + 0] + Pp[row * 4 + 1]) + (Pp[row * 4 + 2] + Pp[row * 4 + 3]);
            unsigned* sl = xbuf + (size_t)(u.pm * BM + row) * 4;
            __hip_atomic_store(sl + u.pn, __float_as_uint(t) | 0x80000000u, __ATOMIC_RELAXED, __HIP_MEMORY_SCOPE_AGENT);
            unsigned w[4]; unsigned sp = 0;
#pragma unroll
            for (int q = 0; q < 4; ++q) w[q] = __hip_atomic_load(sl + q, __ATOMIC_RELAXED, __HIP_MEMORY_SCOPE_AGENT);
            while (!((w[0] & w[1] & w[2] & w[3]) >> 31) && ++sp < (1u << 18)) { __builtin_amdgcn_s_sleep(4);
#pragma unroll
                for (int q = 0; q < 4; ++q) if (!(w[q] >> 31)) w[q] = __hip_atomic_load(sl + q, __ATOMIC_RELAXED, __HIP_MEMORY_SCOPE_AGENT); }
            float tt = 0.f;
#pragma unroll
            for (int q = 0; q < 4; ++q) tt += __uint_as_float(w[q] & 0x7fffffffu);
            S[row] = 1.0f / sqrtf(tt * (1.0f / 1024.0f) + 1e-6f); }
        asm volatile("s_waitcnt vmcnt(0) lgkmcnt(0)" ::: "memory"); __builtin_amdgcn_s_barrier(); asm volatile("" ::: "memory");
        f32x4 gv[2][2];
#pragma unroll
        for (int bj = 0; bj < 2; ++bj)
#pragma unroll
            for (int n = 0; n < 2; ++n) gv[bj][n] = *(const f32x4*)(fg + col0 + bj * HALF + n * 16);
#pragma unroll
        for (int ai = 0; ai < 2; ++ai)
#pragma unroll
            for (int m = 0; m < 4; ++m) { const int r = ai * HALF + wr * 64 + m * 16 + fr; const float rs = S[r]; const size_t off = (size_t)(u.pm * BM + r) * 1024 + col0;
#pragma unroll
                for (int bj = 0; bj < 2; ++bj)
#pragma unroll
                    for (int n = 0; n < 2; ++n) *(f32x4*)(out + off + bj * HALF + n * 16) = acc[ai][bj][m][n] * rs * gv[bj][n]; }
    }
};
template <class Epi, class Sched, bool ALIGN_EPI = false, bool SP2 = false>
__device__ __forceinline__ void gemm_phase(PG8_LAS unsigned char* lds, const Gemm g, const Sched& S, const Epi& E) {
    const int tid = threadIdx.x, wid = __builtin_amdgcn_readfirstlane(tid >> 6), lane = tid & 63, wr = wid >> 2, wc = wid & 3, fr = lane & 15, fq = lane >> 4;
    const int K = g.K, nt = K / BK;
    unsigned voffA[2], voffB[2];
#pragma unroll
    for (int i = 0; i < 2; ++i) { int R, C; stage_rc(tid * 16 + i * 8192, R, C); const int Rb = Epi::PERM ? ((R & ~31) + perm32(R & 31)) : R;
        voffA[i] = (unsigned)(R * K + C) * 2u; voffB[i] = (unsigned)(Rb * K + C) * 2u; }
    const size_t kstep = (size_t)(BK * 2);
    const size_t hstep = (size_t)HALF * K * 2;
    const size_t tstep = 2 * hstep;
    const unsigned ldsw = (unsigned)wid * 1024u;
    const int aoff = lds_byte(wr * 64 + fr, fq * 8), boff = lds_byte(wc * 32 + fr, fq * 8);
#define PG8_SA(b, h) (((b) * 2 + (h)) * HTB)
#define PG8_SB(b, h) ((4 + (b) * 2 + (h)) * HTB)
#define PG8_STAGE(bufoff, gbase, voff) do { _Pragma("unroll") for (int _i = 0; _i < 2; ++_i) \
        __builtin_amdgcn_global_load_lds((const unsigned*)((const char*)(gbase) + (voff)[_i]), (PG8_LAS unsigned*)(lds + (bufoff) + ldsw + _i * 8192), 16, 0, 0); } while (0)
#define PG8_LDA(dst, b, h) do { _Pragma("unroll") for (int m = 0; m < 4; ++m) _Pragma("unroll") for (int k = 0; k < 2; ++k) dst[m][k] = *(const PG8_LAS bf16x8*)(lds + PG8_SA(b, h) + aoff + m * 2048 + k * 1024); } while (0)
#define PG8_LDB(dst, b, h) do { _Pragma("unroll") for (int n = 0; n < 2; ++n) _Pragma("unroll") for (int k = 0; k < 2; ++k) dst[n][k] = *(const PG8_LAS bf16x8*)(lds + PG8_SB(b, h) + boff + n * 2048 + k * 1024); } while (0)
#define PG8_MMA(ai, bj, At, Bt) do { __builtin_amdgcn_s_setprio(1); _Pragma("unroll") for (int m = 0; m < 4; ++m) _Pragma("unroll") for (int n = 0; n < 2; ++n) _Pragma("unroll") for (int k = 0; k < 2; ++k) \
        acc[ai][bj][m][n] = __builtin_amdgcn_mfma_f32_16x16x32_bf16(Bt[n][k], At[m][k], acc[ai][bj][m][n], 0, 0, 0); __builtin_amdgcn_s_setprio(0); } while (0)
#define PG8_WAIT_V(n) asm volatile("s_waitcnt vmcnt(" #n ")" ::: "memory")
#define PG8_WAIT_L(n) asm volatile("s_waitcnt lgkmcnt(" #n ")" ::: "memory")
#define PG8_BAR __builtin_amdgcn_s_barrier()
#define PG8_SCHED __builtin_amdgcn_sched_barrier(0)
    Unit cur, nxt; int ui = 0;
    if (!S.next(0, cur)) return;
    f32x4 acc[2][2][4][2];
#pragma unroll
    for (int a = 0; a < 2; ++a)
#pragma unroll
        for (int b = 0; b < 2; ++b)
#pragma unroll
            for (int m = 0; m < 4; ++m)
#pragma unroll
                for (int n = 0; n < 2; ++n) acc[a][b][m][n] = (f32x4){0.f, 0.f, 0.f, 0.f};
    if constexpr (Epi::HAS_INIT) E.init(acc, cur, wr, wc, fr, fq);
    bf16x8 At[4][2], B0[2][2], B1[2][2];
    const char* cA = (const char*)g.A + (size_t)cur.pm * tstep; const char* cB = (const char*)g.Bt + (size_t)cur.pn * tstep;
    S.a_ready(cur);
    if constexpr (SP2) {
        PG8_STAGE(PG8_SB(0, 0), cB, voffB); PG8_STAGE(PG8_SB(0, 1), cB + hstep, voffB); PG8_STAGE(PG8_SA(0, 0), cA, voffA); PG8_STAGE(PG8_SA(0, 1), cA + hstep, voffA);
        if (wr == 1) PG8_BAR;
        PG8_WAIT_V(2); PG8_BAR;
        PG8_STAGE(PG8_SB(1, 0), cB + kstep, voffB); PG8_STAGE(PG8_SA(1, 0), cA + kstep, voffA); PG8_STAGE(PG8_SB(1, 1), cB + hstep + kstep, voffB);
        PG8_WAIT_V(6); PG8_BAR;
    } else {
        PG8_STAGE(PG8_SB(0, 0), cB, voffB); PG8_STAGE(PG8_SA(0, 0), cA, voffA); PG8_STAGE(PG8_SB(0, 1), cB + hstep, voffB); PG8_STAGE(PG8_SA(0, 1), cA + hstep, voffA);
        if (wr == 1) PG8_BAR;
        PG8_WAIT_V(4); PG8_BAR;
        PG8_STAGE(PG8_SB(1, 0), cB + kstep, voffB); PG8_STAGE(PG8_SA(1, 0), cA + kstep, voffA); PG8_STAGE(PG8_SB(1, 1), cB + hstep + kstep, voffB);
        PG8_WAIT_V(6); PG8_BAR;
    }
    for (;;) {
        const bool has_next = S.next(ui + 1, nxt);
        const char* nA = has_next ? (const char*)g.A + (size_t)nxt.pm * tstep : cA; const char* nB = has_next ? (const char*)g.Bt + (size_t)nxt.pn * tstep : cB;
        for (int t = 0; t < nt; t += 2) {
            const bool last = (t == nt - 2);
            const char* a1 = cA + (size_t)(t + 1) * kstep;
            const char* a2 = last ? nA : cA + (size_t)(t + 2) * kstep; const char* b2 = last ? nB : cB + (size_t)(t + 2) * kstep;
            const char* a3 = a2 + kstep; const char* b3 = b2 + kstep;
            if (last && has_next) S.a_ready(nxt);
            if constexpr (SP2) {
            PG8_LDB(B0, 0, 0); PG8_LDB(B1, 0, 1); PG8_SCHED; PG8_LDA(At, 0, 0); PG8_STAGE(PG8_SA(1, 1), a1 + hstep, voffA);
            PG8_WAIT_V(8); PG8_WAIT_L(0); PG8_BAR; PG8_MMA(0, 0, At, B0); PG8_MMA(0, 1, At, B1); PG8_BAR; PG8_SCHED;
            PG8_LDA(At, 0, 1); PG8_STAGE(PG8_SB(0, 0), b2, voffB); PG8_STAGE(PG8_SB(0, 1), b2 + hstep, voffB); PG8_STAGE(PG8_SA(0, 0), a2, voffA);
            PG8_WAIT_V(8); PG8_WAIT_L(0); PG8_BAR; PG8_MMA(1, 0, At, B0); PG8_MMA(1, 1, At, B1); PG8_BAR; PG8_SCHED;
            PG8_LDB(B0, 1, 0); PG8_LDB(B1, 1, 1); PG8_SCHED; PG8_LDA(At, 1, 0); PG8_STAGE(PG8_SA(0, 1), a2 + hstep, voffA);
            PG8_WAIT_V(8); PG8_WAIT_L(0); PG8_BAR; PG8_MMA(0, 0, At, B0); PG8_MMA(0, 1, At, B1); PG8_BAR; PG8_SCHED;
            PG8_LDA(At, 1, 1); PG8_STAGE(PG8_SB(1, 0), b3, voffB); PG8_STAGE(PG8_SB(1, 1), b3 + hstep, voffB); PG8_STAGE(PG8_SA(1, 0), a3, voffA);
            PG8_WAIT_V(8); PG8_WAIT_L(0); PG8_BAR; PG8_MMA(1, 0, At, B0); PG8_MMA(1, 1, At, B1); PG8_BAR; PG8_SCHED;
            } else {
            PG8_LDB(B0, 0, 0); PG8_SCHED; PG8_LDA(At, 0, 0); PG8_STAGE(PG8_SA(1, 1), a1 + hstep, voffA);
            PG8_WAIT_L(8); PG8_BAR; PG8_WAIT_L(0); PG8_MMA(0, 0, At, B0); PG8_BAR; PG8_SCHED;
            PG8_LDB(B1, 0, 1); PG8_STAGE(PG8_SB(0, 0), b2, voffB);
            PG8_BAR; PG8_WAIT_L(0); PG8_MMA(0, 1, At, B1); PG8_BAR;
            PG8_LDA(At, 0, 1); PG8_STAGE(PG8_SA(0, 0), a2, voffA);
            PG8_BAR; PG8_WAIT_L(0); PG8_MMA(1, 0, At, B0); PG8_BAR; PG8_SCHED;
            PG8_STAGE(PG8_SB(0, 1), b2 + hstep, voffB);
            PG8_WAIT_V(6); PG8_BAR; PG8_MMA(1, 1, At, B1); PG8_BAR;
            PG8_LDB(B0, 1, 0); PG8_SCHED; PG8_LDA(At, 1, 0); PG8_STAGE(PG8_SA(0, 1), a2 + hstep, voffA);
            PG8_WAIT_L(8); PG8_BAR; PG8_WAIT_L(0); PG8_MMA(0, 0, At, B0); PG8_BAR; PG8_SCHED;
            PG8_LDB(B1, 1, 1); PG8_STAGE(PG8_SB(1, 0), b3, voffB);
            PG8_BAR; PG8_WAIT_L(0); PG8_MMA(0, 1, At, B1); PG8_BAR;
            PG8_LDA(At, 1, 1); PG8_STAGE(PG8_SA(1, 0), a3, voffA);
            PG8_BAR; PG8_WAIT_L(0); PG8_MMA(1, 0, At, B0); PG8_BAR; PG8_SCHED;
            PG8_STAGE(PG8_SB(1, 1), b3 + hstep, voffB);
            PG8_WAIT_V(6); PG8_BAR; PG8_MMA(1, 1, At, B1); PG8_BAR;
            }
        }
        if constexpr (ALIGN_EPI) { if (wr == 0) PG8_BAR; }
        if constexpr (!Epi::AFTER_DRAIN) { E(acc, cur, wr, wc, fr, fq); S.done(cur); }
        if (!has_next) break;
#pragma unroll
        for (int a = 0; a < 2; ++a)
#pragma unroll
            for (int b = 0; b < 2; ++b)
#pragma unroll
                for (int m = 0; m < 4; ++m)
#pragma unroll
                    for (int n = 0; n < 2; ++n) acc[a][b][m][n] = (f32x4){0.f, 0.f, 0.f, 0.f};
        cur = nxt; cA = nA; cB = nB; ++ui;
        if constexpr (ALIGN_EPI) { if (wr == 1) PG8_BAR; }
    }
    PG8_WAIT_V(0);
    if constexpr (!ALIGN_EPI) { if (wr == 0) PG8_BAR; }
    PG8_BAR;
    if constexpr (Epi::AFTER_DRAIN) { E.fused(acc, cur, wr, wc, fr, fq, lds, wid, lane); S.done(cur); }
#undef PG8_SA
#undef PG8_SB
#undef PG8_STAGE
#undef PG8_LDA
#undef PG8_LDB
#undef PG8_MMA
#undef PG8_WAIT_V
#undef PG8_WAIT_L
#undef PG8_BAR
#undef PG8_SCHED
}
}
constexpr int BATCH = 4, SEQ = 4096, DM = 1024, NMETA = 16, MROWS = BATCH * SEQ;
constexpr int NHD = 8, LBLK = 128, DK = 64, DV = 128, CHK = 128, NCHK = SEQ / CHK;
constexpr int INW = 5120, MIXW = 2048, MPW = 2560;
constexpr int TPOS = NMETA + SEQ;
constexpr float EPSN = 1e-6f;
constexpr size_t MiB = 1u << 20;
constexpr size_t WS_RSTD = 0;
constexpr size_t WS_SP = 64 * 1024;
constexpr size_t WS_MSLOT = 248 * MiB + 512 * 1024;
constexpr size_t WS_HMETA = 68 * 1024;
constexpr size_t WS_METAP = 72 * 1024;
constexpr size_t WS_BAR = 232 * 1024;
constexpr size_t WS_CNT = WS_BAR + 16384;
constexpr size_t WS_PCNT = WS_CNT + 4096 + 64;
constexpr size_t WS_ZERO_BYTES = 16384 + 4096 + 64 + 256;
constexpr size_t WS_KVM = 256 * 1024;
constexpr size_t WS_WGT = 512 * 1024;
constexpr size_t WS_ROT = 1 * MiB;
constexpr size_t WS_LSUM = 2 * MiB + 512 * 1024;
constexpr size_t WS_LCARRY = 3 * MiB + 512 * 1024;
constexpr size_t WS_W2T = 4 * MiB;
constexpr size_t WS_Y = 8 * MiB;
constexpr size_t WS_HB = 8 * MiB;
constexpr size_t WS_W1T = 40 * MiB;
constexpr size_t WS_LX = 72 * MiB, WS_LG = 104 * MiB, WS_Q = 136 * MiB, WS_KK = 152 * MiB, WS_V = 168 * MiB, WS_RG = 200 * MiB;
constexpr size_t WS_RPREV = 232 * MiB;
constexpr size_t WS_XBUF = 248 * MiB;
constexpr size_t WS_END = 249 * MiB;

typedef unsigned short bf16;
typedef unsigned u32x4 __attribute__((ext_vector_type(4)));
typedef float f32x4 __attribute__((ext_vector_type(4)));
typedef float f32x2 __attribute__((ext_vector_type(2)));
typedef short bf16x8 __attribute__((ext_vector_type(8)));
typedef short s16x4 __attribute__((ext_vector_type(4)));
#define LAS __attribute__((address_space(3)))

DI float bf2f(bf16 b) { return __uint_as_float(((unsigned)b) << 16); }
typedef __bf16 bf16x2_t __attribute__((ext_vector_type(2)));
DI bf16 f2bf(float f) { return __builtin_bit_cast(unsigned short, (__bf16)f); }
DI unsigned pk2(float lo, float hi) { bf16x2_t v = {(__bf16)lo, (__bf16)hi}; return __builtin_bit_cast(unsigned, v); }
DI float sigm(float x) { return 1.f / (1.f + __expf(-x)); }
DI float loggh(int h) { return log1pf(-exp2f(-5.0f - (float)h)); }
DI int w1_src_col(int np) { if (np >= 2048 && np < 3072) { const int hb = np & ~63, c = np & 63; return hb + (c >> 1) + 32 * (c & 1); } return np; }
DI int metap_src_col(int j) { return j < 1024 ? j : (j < 1536 ? 2560 + (j - 1024) : 3072 + (j - 1536)); }
DI float wave_sum(float v) {
#pragma unroll
    for (int o = 1; o < 64; o <<= 1) v += __shfl_xor(v, o);
    return v;
}

struct Ptrs {
    const float *x, *meta, *ngain, *w_in, *conv_w, *conv_b, *w_rg, *b_rg, *w_ig, *b_ig, *lam, *rng, *w_out, *fgain;
    float* out; unsigned char* ws;
};
#define WSP(T, off) ((T*)(P.ws + (off)))

DI void row_to_bf16(const float* xrow, bf16* orow, float* rstd_out, int lane) {
    const f32x4* xr = (const f32x4*)xrow + lane; f32x4 v[4]; float s = 0.f;
#pragma unroll
    for (int j = 0; j < 4; ++j) { v[j] = xr[64 * j]; s += (v[j].x * v[j].x + v[j].y * v[j].y) + (v[j].z * v[j].z + v[j].w * v[j].w); }
    s = wave_sum(s);
    if (lane == 0) *rstd_out = 1.0f / sqrtf(s * (1.0f / DM) + EPSN);
    unsigned long long* o8 = (unsigned long long*)orow + lane;
#pragma unroll
    for (int j = 0; j < 4; ++j) o8[64 * j] = (unsigned long long)pk2(v[j].x, v[j].y) | ((unsigned long long)pk2(v[j].z, v[j].w) << 32);
}
DI void final_norm_row(float* row, const float* g, int lane) {
    f32x4* xr = (f32x4*)row + lane; const f32x4* gr = (const f32x4*)g + lane; f32x4 v[4]; float s = 0.f;
#pragma unroll
    for (int j = 0; j < 4; ++j) { v[j] = xr[64 * j]; s += (v[j].x * v[j].x + v[j].y * v[j].y) + (v[j].z * v[j].z + v[j].w * v[j].w); }
    s = wave_sum(s); const float rs = 1.0f / sqrtf(s * (1.0f / DM) + EPSN);
#pragma unroll
    for (int j = 0; j < 4; ++j) xr[64 * j] = v[j] * rs * gr[64 * j];
}
DI void rot_sp_entry(const Ptrs& P, int idx) {
    if (idx < TPOS * 32) { const int pos = idx >> 5, i = idx & 31; const double inv = pow(10000.0, -(double)i / 32.0); const double ang = (double)pos * inv;
        WSP(f32x2, WS_ROT)[idx] = (f32x2){(float)cos(ang), (float)sin(ang)}; }
    else { const int c = idx - TPOS * 32; WSP(float, WS_SP)[c] = log1pf(expf(-P.lam[c])); }
}

__global__ void n0_rows(Ptrs P) { const int gw = (blockIdx.x * blockDim.x + threadIdx.x) >> 6, lane = threadIdx.x & 63; if (gw < MROWS) row_to_bf16(P.x + (size_t)gw * DM, WSP(bf16, WS_HB) + (size_t)gw * DM, WSP(float, WS_RSTD) + gw, lane); }
__global__ void n0_misc(Ptrs P) { const int idx = blockIdx.x * blockDim.x + threadIdx.x; if (idx < TPOS * 32 + 1024) rot_sp_entry(P, idx); }
__global__ void n0_w1t(Ptrs P) { const int idx = blockIdx.x * blockDim.x + threadIdx.x; if (idx >= INW * DM) return; const int np = idx >> 10, k = idx & 1023;
    WSP(bf16, WS_W1T)[idx] = f2bf(P.ngain[k] * P.w_in[(size_t)k * INW + w1_src_col(np)]); }
__global__ void n0_w2t(Ptrs P) { const int idx = blockIdx.x * blockDim.x + threadIdx.x; if (idx >= DM * MIXW) return; const int n = idx >> 11, k = idx & 2047;
    WSP(bf16, WS_W2T)[idx] = f2bf(P.w_out[(size_t)k * DM + n]); }
__global__ void n0_wgt(Ptrs P) { const int idx = blockIdx.x * blockDim.x + threadIdx.x; if (idx >= 2 * 8 * 128 * 128) return;
    const int g = idx >> 17, hh = (idx >> 14) & 7, n = (idx >> 7) & 127, k = idx & 127; const float* w = g ? P.w_ig : P.w_rg;
    WSP(bf16, WS_WGT)[idx] = f2bf(-1.44269504089f * w[(hh * 128 + k) * 128 + n]); }
__global__ void n0_meta(Ptrs P) { const int idx = blockIdx.x * blockDim.x + threadIdx.x; if (idx >= NMETA * MPW) return; const int r = idx / MPW, j = idx % MPW; const int col = metap_src_col(j);
    float ss = 0.f; for (int k = 0; k < DM; ++k) { const float v = P.meta[r * DM + k]; ss += v * v; }
    const float rs = 1.0f / sqrtf(ss * (1.0f / DM) + EPSN); float acc = 0.f;
    for (int k = 0; k < DM; ++k) acc += P.meta[r * DM + k] * rs * P.ngain[k] * P.w_in[(size_t)k * INW + col];
    WSP(float, WS_METAP)[idx] = acc; }
__global__ void n1_gemm1(Ptrs P) {
    const size_t idx = (size_t)blockIdx.x * blockDim.x + threadIdx.x; if (idx >= (size_t)MROWS * (INW / 2)) return;
    const int row = (int)(idx / (INW / 2)), p = (int)(idx % (INW / 2)), np = 2 * p;
    const u32x4* a = (const u32x4*)(WSP(bf16, WS_HB) + (size_t)row * DM); const u32x4* b0 = (const u32x4*)(WSP(bf16, WS_W1T) + (size_t)np * DM); const u32x4* b1 = b0 + DM / 8;
    float s0 = 0.f, s1 = 0.f;
    for (int k8 = 0; k8 < DM / 8; ++k8) { const u32x4 av = a[k8], v0 = b0[k8], v1 = b1[k8];
#pragma unroll
        for (int j = 0; j < 4; ++j) { const float al = __uint_as_float(av[j] << 16), ah = __uint_as_float(av[j] & 0xffff0000u);
            s0 += al * __uint_as_float(v0[j] << 16) + ah * __uint_as_float(v0[j] & 0xffff0000u); s1 += al * __uint_as_float(v1[j] << 16) + ah * __uint_as_float(v1[j] & 0xffff0000u); } }
    const float rs = WSP(float, WS_RSTD)[row]; s0 *= rs; s1 *= rs;
    bf16* dst; int ldc, col;
    if (np < 1024) { dst = WSP(bf16, WS_LX); ldc = 1024; col = np; }
    else if (np < 2048) { dst = WSP(bf16, WS_LG); ldc = 1024; col = np - 1024; s0 = s0 / (1.f + __expf(-s0)); s1 = s1 / (1.f + __expf(-s1)); }
    else if (np < 3072) { const bool isk = np >= 2560; dst = isk ? WSP(bf16, WS_KK) : WSP(bf16, WS_Q); ldc = 512; col = np - (isk ? 2560 : 2048);
        const int i = (np & 63) >> 1, pos = NMETA + (row & (SEQ - 1)); const f32x2 cs = WSP(f32x2, WS_ROT)[pos * 32 + i]; const float sc = isk ? 0.125f : 1.f;
        const float a1 = s0, a2 = s1; s0 = (a1 * cs.x - a2 * cs.y) * sc; s1 = (a1 * cs.y + a2 * cs.x) * sc; }
    else if (np < 4096) { dst = WSP(bf16, WS_V); ldc = 1024; col = np - 3072; }
    else { dst = WSP(bf16, WS_RG); ldc = 1024; col = np - 4096; s0 = s0 / (1.f + __expf(-s0)); s1 = s1 / (1.f + __expf(-s1)); }
    *(unsigned*)(dst + (size_t)row * ldc + col) = pk2(s0, s1);
}
__global__ void __launch_bounds__(128) n_lru(Ptrs P) {
    extern __shared__ float nsm[]; float* wr = nsm; float* wi = nsm + 128 * 128; float* xcs = nsm + 2 * 128 * 128;
    const int b = blockIdx.x >> 3, hh = blockIdx.x & 7, c = threadIdx.x, ch = hh * 128 + c;
    for (int i = c; i < 128 * 128; i += 128) { wr[i] = P.w_rg[hh * 16384 + i]; wi[i] = P.w_ig[hh * 16384 + i]; }
    const float cw0 = P.conv_w[ch], cw1 = P.conv_w[1024 + ch], cw2 = P.conv_w[2048 + ch], cw3 = P.conv_w[3072 + ch], cb = P.conv_b[ch];
    const float brg = P.b_rg[ch], big = P.b_ig[ch], sp = WSP(float, WS_SP)[ch];
    float x0 = 0.f, x1 = 0.f, x2 = 0.f, h = 0.f;
    for (int tt = 0; tt < TPOS; ++tt) {
        const size_t row = (size_t)b * SEQ + (tt - NMETA);
        const float xin = tt < NMETA ? WSP(float, WS_METAP)[tt * MPW + ch] : bf2f(WSP(bf16, WS_LX)[row * 1024 + ch]);
        const float xcv = cb + cw0 * x0 + cw1 * x1 + cw2 * x2 + cw3 * xin; x0 = x1; x1 = x2; x2 = xin;
        __syncthreads(); xcs[c] = xcv; __syncthreads();
        float rp = brg, ip = big;
        for (int ci = 0; ci < 128; ++ci) { const float xv = xcs[ci]; rp += xv * wr[ci * 128 + c]; ip += xv * wi[ci * 128 + c]; }
        const float r = sigm(rp), ig = sigm(ip), la = -8.0f * r * sp, a = expf(la), beta = sqrtf(-expm1f(2.0f * la));
        h = a * h + beta * ig * xcv;
        if (tt >= NMETA) WSP(bf16, WS_Y)[row * MIXW + ch] = f2bf(h * bf2f(WSP(bf16, WS_LG)[row * 1024 + ch]));
    }
}
__global__ void __launch_bounds__(128) n_ret(Ptrs P) {
    __shared__ float ks[64], qs[64], red[4];
    const int b = blockIdx.x >> 3, h = blockIdx.x & 7, e = threadIdx.x, lane = e & 63, wv = e >> 6;
    const float g = expf(loggh(h)), gn = P.rng[h * 128 + e];
    float S[64];
#pragma unroll
    for (int d = 0; d < 64; ++d) S[d] = 0.f;
    for (int tt = 0; tt < TPOS; ++tt) {
        const size_t row = (size_t)b * SEQ + (tt - NMETA); float v;
        __syncthreads();
        if (tt < NMETA) { const float* mp = WSP(float, WS_METAP) + tt * MPW;
            if (e < 32) { const float x1 = mp[1024 + h * 64 + e], x2 = mp[1024 + h * 64 + 32 + e]; const f32x2 cs = WSP(f32x2, WS_ROT)[tt * 32 + e];
                ks[2 * e] = (x1 * cs.x - x2 * cs.y) * 0.125f; ks[2 * e + 1] = (x1 * cs.y + x2 * cs.x) * 0.125f; qs[2 * e] = 0.f; qs[2 * e + 1] = 0.f; }
            v = mp[1536 + h * 128 + e]; }
        else { if (e < 64) { ks[e] = bf2f(WSP(bf16, WS_KK)[row * 512 + h * 64 + e]); qs[e] = bf2f(WSP(bf16, WS_Q)[row * 512 + h * 64 + e]); }
            v = bf2f(WSP(bf16, WS_V)[row * 1024 + h * 128 + e]); }
        __syncthreads();
        float o = 0.f;
#pragma unroll
        for (int d = 0; d < 64; ++d) { S[d] = g * S[d] + ks[d] * v; o += qs[d] * S[d]; }
        if (tt >= NMETA) {
            float s = wave_sum(o); if (lane == 0) red[wv] = s; __syncthreads(); const float mu = (red[0] + red[1]) * (1.0f / 128.0f);
            const float dlt = o - mu; float q = wave_sum(dlt * dlt); if (lane == 0) red[2 + wv] = q; __syncthreads(); const float var = (red[2] + red[3]) * (1.0f / 128.0f);
            const float y = dlt * (1.0f / sqrtf(var + EPSN)) * gn * bf2f(WSP(bf16, WS_RG)[row * 1024 + h * 128 + e]);
            WSP(bf16, WS_Y)[row * MIXW + 1024 + h * 128 + e] = f2bf(y);
        }
    }
}
__global__ void n5_gemm2(Ptrs P) {
    const size_t idx = (size_t)blockIdx.x * blockDim.x + threadIdx.x; if (idx >= (size_t)MROWS * (DM / 2)) return;
    const int row = (int)(idx / (DM / 2)), n = 2 * (int)(idx % (DM / 2));
    const u32x4* a = (const u32x4*)(WSP(bf16, WS_Y) + (size_t)row * MIXW); const u32x4* b0 = (const u32x4*)(WSP(bf16, WS_W2T) + (size_t)n * MIXW); const u32x4* b1 = b0 + MIXW / 8;
    float s0 = 0.f, s1 = 0.f;
    for (int k8 = 0; k8 < MIXW / 8; ++k8) { const u32x4 av = a[k8], v0 = b0[k8], v1 = b1[k8];
#pragma unroll
        for (int j = 0; j < 4; ++j) { const float al = __uint_as_float(av[j] << 16), ah = __uint_as_float(av[j] & 0xffff0000u);
            s0 += al * __uint_as_float(v0[j] << 16) + ah * __uint_as_float(v0[j] & 0xffff0000u); s1 += al * __uint_as_float(v1[j] << 16) + ah * __uint_as_float(v1[j] & 0xffff0000u); } }
    const size_t o = (size_t)row * DM + n; P.out[o] = P.x[o] + s0; P.out[o + 1] = P.x[o + 1] + s1;
}
__global__ void n6_norm(Ptrs P) { const int gw = (blockIdx.x * blockDim.x + threadIdx.x) >> 6, lane = threadIdx.x & 63; if (gw < MROWS) final_norm_row(P.out + (size_t)gw * DM, P.fgain, lane); }
constexpr int NT = 512;
constexpr int LDS_BYTES = 147456;
DI s16x4 tr_read(const LAS unsigned char* p) { return __builtin_amdgcn_ds_read_tr16_b64_v4i16((LAS s16x4*)p); }
DI bf16x8 cat8(s16x4 a, s16x4 b) { return __builtin_shufflevector(a, b, 0, 1, 2, 3, 4, 5, 6, 7); }
#define MFMA16(a, b, c) __builtin_amdgcn_mfma_f32_16x16x32_bf16((a), (b), (c), 0, 0, 0)

template <int CMAP>
DI void p0_transpose_item(const float* W, int K, int N, int ldw, bf16* WT, const float* gain, LAS float* scr, int item, int lane, float scale = 1.0f) {
    const int nblk = N / 32, kb = item / nblk, nb = item % nblk, k0 = 64 * kb, n0 = 32 * nb;
    const int scol = CMAP ? w1_src_col(n0 + (lane & 31)) : n0 + (lane & 31);
    float wv[32];
#pragma unroll
    for (int i = 0; i < 32; ++i) wv[i] = __builtin_nontemporal_load(W + (size_t)(k0 + 2 * i + (lane >> 5)) * ldw + scol);
#pragma unroll
    for (int i = 0; i < 32; ++i) { const int kk = 2 * i + (lane >> 5); float v = wv[i] * scale; if (gain) v *= gain[k0 + kk]; scr[kk * 33 + (lane & 31)] = v; }
    asm volatile("s_waitcnt lgkmcnt(0)" ::: "memory");
    const int c = lane & 7;
#pragma unroll
    for (int j = 0; j < 4; ++j) { const int n = (lane >> 3) + 8 * j; const LAS float* s = scr + (8 * c) * 33 + n;
        u32x4 o; o.x = pk2(s[0 * 33], s[1 * 33]); o.y = pk2(s[2 * 33], s[3 * 33]); o.z = pk2(s[4 * 33], s[5 * 33]); o.w = pk2(s[6 * 33], s[7 * 33]);
        *(u32x4*)(WT + (size_t)(n0 + n) * K + k0 + 8 * c) = o; }
    asm volatile("s_waitcnt lgkmcnt(0)" ::: "memory");
}
DI void p0_meta_block(const Ptrs& P, LAS unsigned char* lds, int blk, int tid) {
    LAS float* mu = (LAS float*)lds;
    LAS float* red = (LAS float*)(lds + 65536);
    const int wave = tid >> 6, lane = tid & 63;
    for (int rr = 0; rr < 2; ++rr) { const int r = 2 * wave + rr; const f32x4* xr = (const f32x4*)(P.meta + r * DM) + lane; const f32x4* gr = (const f32x4*)P.ngain + lane; f32x4 v[4]; float s = 0.f;
#pragma unroll
        for (int j = 0; j < 4; ++j) { v[j] = xr[64 * j]; s += (v[j].x * v[j].x + v[j].y * v[j].y) + (v[j].z * v[j].z + v[j].w * v[j].w); }
        s = wave_sum(s); const float rs = 1.0f / sqrtf(s * (1.0f / DM) + EPSN);
#pragma unroll
        for (int j = 0; j < 4; ++j) *(LAS f32x4*)(mu + r * 1024 + 4 * (lane + 64 * j)) = v[j] * rs * gr[64 * j]; }
    __syncthreads();
    const int c2 = tid & 7, kg = tid >> 3; const int col = metap_src_col(16 * blk + 2 * c2);
    float acc0[16], acc1[16]; f32x2 wv[16];
#pragma unroll
    for (int r = 0; r < 16; ++r) { acc0[r] = 0.f; acc1[r] = 0.f; }
#pragma unroll
    for (int i = 0; i < 16; ++i) wv[i] = __builtin_nontemporal_load((const f32x2*)(P.w_in + (size_t)(kg + 64 * i) * INW + col));
#pragma unroll
    for (int i = 0; i < 16; ++i) { const int k = kg + 64 * i;
#pragma unroll
        for (int r = 0; r < 16; ++r) { const float m = mu[r * 1024 + k]; acc0[r] += m * wv[i].x; acc1[r] += m * wv[i].y; } }
#pragma unroll
    for (int r = 0; r < 16; ++r) { red[(kg * 16 + r) * 16 + 2 * c2] = acc0[r]; red[(kg * 16 + r) * 16 + 2 * c2 + 1] = acc1[r]; }
    __syncthreads();
    if (tid < 256) { const int r = tid >> 4, cc = tid & 15; float s = 0.f; for (int g = 0; g < 64; ++g) s += red[(g * 16 + r) * 16 + cc];
        WSP(float, WS_METAP)[r * MPW + 16 * blk + cc] = s; }
    __syncthreads();
}
DI void p0_prologue(const Ptrs& P, LAS unsigned char* lds, int tid) {
    const int wave = tid >> 6, lane = tid & 63, G = gridDim.x;
    if ((int)blockIdx.x < MPW / 16) p0_meta_block(P, lds, blockIdx.x, tid);
    LAS float* scr = (LAS float*)(lds + wave * 16384);
    const int gw = blockIdx.x * 8 + wave, NGW = G * 8;
    constexpr int I1 = (DM / 64) * (INW / 32), I2 = (MIXW / 64) * (DM / 32), IG = 2 * 8;
    for (int it = gw; it < I1 + I2 + 16 * 8; it += NGW) {
        int r = it;
        if (r < I1) { p0_transpose_item<1>(P.w_in, DM, INW, INW, WSP(bf16, WS_W1T), P.ngain, scr, r, lane); continue; } r -= I1;
        if (r < I2) { p0_transpose_item<0>(P.w_out, MIXW, DM, DM, WSP(bf16, WS_W2T), nullptr, scr, r, lane); continue; } r -= I2;
        const int mat = r >> 3, sub = r & 7; const float* w = (mat < 8 ? P.w_rg : P.w_ig) + (mat & 7) * 16384;
        p0_transpose_item<0>(w, 128, 128, 128, WSP(bf16, WS_WGT) + mat * 16384, nullptr, scr, sub, lane, -1.44269504089f);
    }
    (void)IG;
    for (int m0 = gw; m0 < MROWS; m0 += 4 * NGW) {
        f32x4 v[4][4];
#pragma unroll
        for (int r = 0; r < 4; ++r) { const int m = m0 + r * NGW; if (m < MROWS) { const f32x4* xr = (const f32x4*)(P.x + (size_t)m * DM) + lane;
#pragma unroll
            for (int j = 0; j < 4; ++j) v[r][j] = __builtin_nontemporal_load(xr + 64 * j); } }
#pragma unroll
        for (int r = 0; r < 4; ++r) { const int m = m0 + r * NGW; if (m < MROWS) { float ss = 0.f;
#pragma unroll
            for (int j = 0; j < 4; ++j) ss += (v[r][j].x * v[r][j].x + v[r][j].y * v[r][j].y) + (v[r][j].z * v[r][j].z + v[r][j].w * v[r][j].w);
            ss = wave_sum(ss); if (lane == 0) WSP(float, WS_RSTD)[m] = 1.0f / sqrtf(ss * (1.0f / DM) + EPSN);
            unsigned long long* o8 = (unsigned long long*)(WSP(bf16, WS_HB) + (size_t)m * DM) + lane;
#pragma unroll
            for (int j = 0; j < 4; ++j) o8[64 * j] = (unsigned long long)pk2(v[r][j].x, v[r][j].y) | ((unsigned long long)pk2(v[r][j].z, v[r][j].w) << 32); } }
    }
    for (int idx = blockIdx.x * NT + tid; idx < TPOS * 32 + 1024; idx += G * NT) rot_sp_entry(P, idx);
    for (int idx = blockIdx.x * NT + tid; idx < 65536; idx += G * NT) WSP(unsigned, WS_XBUF)[idx] = 0u;
    for (int idx = blockIdx.x * NT + tid; idx < BATCH * NCHK * 1024 + 1024; idx += G * NT) { if (idx < BATCH * NCHK * 1024) WSP(unsigned long long, WS_LSUM)[idx] = 0ull; else WSP(unsigned long long, WS_MSLOT)[idx - BATCH * NCHK * 1024] = 0ull; }
}

DI float fsig(float x) { return __builtin_amdgcn_rcpf(1.0f + __expf(-x)); }
DI float beta_from(float la, float a) {
    const float y = 2.0f * la;
    float p = 1.0f + y * (1.0f / 7.0f); p = 1.0f + y * (1.0f / 6.0f) * p; p = 1.0f + y * (1.0f / 5.0f) * p; p = 1.0f + y * (1.0f / 4.0f) * p; p = 1.0f + y * (1.0f / 3.0f) * p; p = 1.0f + y * 0.5f * p;
    const float small = -y * p, big = 1.0f - a * a;
    return __builtin_amdgcn_sqrtf(y > -0.5f ? small : big);
}
DI float fsig2(float z2) { return __builtin_amdgcn_rcpf(1.0f + __builtin_amdgcn_exp2f(z2)); }
DI float beta_from2(float la2, float a) {
    const float y = 1.38629436112f * la2, q = y * y;
    const float s1 = 1.0f + 0.5f * y, s2 = (1.0f / 6.0f) + (1.0f / 24.0f) * y, p = s1 + q * s2;
    const float small = -y * p, big = 1.0f - a * a;
    return __builtin_amdgcn_sqrtf(y > -0.2f ? small : big);
}
struct LruConst { bf16x8 br[4], bi[4]; float brg, big, sp2; int hh; };
DI void lru_const_load(const Ptrs& P, LruConst& C, int hh, int tid) {
    const int wave = __builtin_amdgcn_readfirstlane(tid >> 6), lane = tid & 63, li = lane & 15, lq = lane >> 4, cl = 16 * wave + li, ch = hh * 128 + cl;
#pragma unroll
    for (int kb = 0; kb < 4; ++kb) { C.br[kb] = *(const bf16x8*)(WSP(bf16, WS_WGT) + ((size_t)(0 * 8 + hh) * 128 + cl) * 128 + 32 * kb + 8 * lq);
                                      C.bi[kb] = *(const bf16x8*)(WSP(bf16, WS_WGT) + ((size_t)(1 * 8 + hh) * 128 + cl) * 128 + 32 * kb + 8 * lq); }
    C.brg = -1.44269504089f * P.b_rg[ch]; C.big = -1.44269504089f * P.b_ig[ch]; C.sp2 = -8.0f * 1.44269504089f * WSP(float, WS_SP)[ch]; C.hh = hh;
}
DI void lru_tile(const Ptrs& P, LAS unsigned char* lds, int b, int n, int hh, int tid, LruConst& C) {
    LAS unsigned char* XA = lds;
    LAS float* XF = (LAS float*)(lds + 34816);
    const int wave = __builtin_amdgcn_readfirstlane(tid >> 6), lane = tid & 63, li = lane & 15, lq = lane >> 4;
    const size_t row0 = (size_t)b * SEQ + (size_t)n * CHK;
    const int cl = 16 * wave + li, ch = hh * 128 + cl;
    const int cg = tid & 15, ch0 = hh * 128 + cg * 8, tb = tid >> 4;
    if (C.hh != hh) lru_const_load(P, C, hh, tid);
    f32x4 cw[4][2], cbv[2];
#pragma unroll
    for (int k = 0; k < 4; ++k) { cw[k][0] = *(const f32x4*)(P.conv_w + k * 1024 + ch0); cw[k][1] = *(const f32x4*)(P.conv_w + k * 1024 + ch0 + 4); }
    cbv[0] = *(const f32x4*)(P.conv_b + ch0); cbv[1] = *(const f32x4*)(P.conv_b + ch0 + 4);
    u32x4 raw[4][4], lgraw[4];
#pragma unroll
    for (int it = 0; it < 4; ++it) lgraw[it] = __builtin_nontemporal_load((const u32x4*)(WSP(bf16, WS_LG) + (row0 + tb + 32 * it) * 1024 + ch0));
#pragma unroll
    for (int it = 0; it < 4; ++it)
#pragma unroll
        for (int k = 0; k < 4; ++k) {
            const int tg = n * CHK + tb + 32 * it - 3 + k;
            if (tg >= 0) raw[it][k] = *(const u32x4*)(WSP(bf16, WS_LX) + ((size_t)b * SEQ + tg) * 1024 + ch0);
            else { const float* mp = WSP(float, WS_METAP) + (NMETA + tg) * MPW + ch0; const f32x4 m0 = *(const f32x4*)mp, m1 = *(const f32x4*)(mp + 4);
                raw[it][k] = (u32x4){pk2(m0[0], m0[1]), pk2(m0[2], m0[3]), pk2(m1[0], m1[1]), pk2(m1[2], m1[3])}; }
        }
    __syncthreads();
#pragma unroll
    for (int it = 0; it < 4; ++it) {
        const int t = tb + 32 * it;
        f32x4 x0 = cbv[0], x1 = cbv[1];
#pragma unroll
        for (int k = 0; k < 4; ++k) { const u32x4 w = raw[it][k];
            const f32x4 lo = (f32x4){__uint_as_float(w[0] << 16), __uint_as_float(w[0] & 0xffff0000u), __uint_as_float(w[1] << 16), __uint_as_float(w[1] & 0xffff0000u)};
            const f32x4 hi = (f32x4){__uint_as_float(w[2] << 16), __uint_as_float(w[2] & 0xffff0000u), __uint_as_float(w[3] << 16), __uint_as_float(w[3] & 0xffff0000u)};
            x0 += cw[k][0] * lo; x1 += cw[k][1] * hi; }
        u32x4 pk; pk.x = pk2(x0[0], x0[1]); pk.y = pk2(x0[2], x0[3]); pk.z = pk2(x1[0], x1[1]); pk.w = pk2(x1[2], x1[3]);
        *(LAS u32x4*)(XA + t * 272 + cg * 16) = pk;
        *(LAS f32x4*)(XF + t * 132 + cg * 8) = x0;
        *(LAS f32x4*)(XF + t * 132 + cg * 8 + 4) = x1;
    }
    const float brg = C.brg, big = C.big, sp2 = C.sp2;
    float carry = 0.f;
    __syncthreads();
    f32x4 ar[8], ai[8];
#pragma unroll
    for (int m = 0; m < 8; ++m) { ar[m] = (f32x4){brg, brg, brg, brg}; ai[m] = (f32x4){big, big, big, big};
#pragma unroll
        for (int kb = 0; kb < 4; ++kb) { const bf16x8 a = *(const LAS bf16x8*)(XA + (16 * m + li) * 272 + (32 * kb + 8 * lq) * 2);
            ar[m] = MFMA16(a, C.br[kb], ar[m]); ai[m] = MFMA16(a, C.bi[kb], ai[m]); } }
    float ptot = 1.f;
#pragma unroll
    for (int m = 0; m < 8; ++m) {
        float a[4], u[4];
#pragma unroll
        for (int rg = 0; rg < 4; ++rg) { const int t = 16 * m + 4 * lq + rg; const float xcv = XF[t * 132 + cl];
            const float r = fsig2(ar[m][rg]), ig = fsig2(ai[m][rg]), la2 = r * sp2;
            a[rg] = __builtin_amdgcn_exp2f(la2); u[rg] = beta_from2(la2, a[rg]) * ig * xcv; }
        float A = a[0], H = u[0];
#pragma unroll
        for (int rg = 1; rg < 4; ++rg) { H = a[rg] * H + u[rg]; A *= a[rg]; }
        const float A1 = __shfl_up(A, 16), H1 = __shfl_up(H, 16);
        if (lq >= 1) { H = A * H1 + H; A = A * A1; }
        const float A2 = __shfl_up(A, 32), H2 = __shfl_up(H, 32);
        if (lq >= 2) { H = A * H2 + H; A = A * A2; }
        float Ae = __shfl_up(A, 16), He = __shfl_up(H, 16); if (lq == 0) { Ae = 1.f; He = 0.f; }
        const float At = __shfl(A, li + 48), Ht = __shfl(H, li + 48);
        float hin = He + Ae * carry, pin = Ae * ptot;
#pragma unroll
        for (int rg = 0; rg < 4; ++rg) { hin = a[rg] * hin + u[rg]; pin *= a[rg]; ar[m][rg] = hin; ai[m][rg] = pin; }
        carry = Ht + At * carry; ptot *= At;
    }
    unsigned long long* lsum = WSP(unsigned long long, WS_LSUM); unsigned long long* mslot = WSP(unsigned long long, WS_MSLOT);
    if (lq == 0) __hip_atomic_store(lsum + ((size_t)b * NCHK + n) * 1024 + ch, ((unsigned long long)__float_as_uint(carry) << 32) | (__float_as_uint(ptot) | 0x80000000u), __ATOMIC_RELAXED, __HIP_MEMORY_SCOPE_AGENT);
    unsigned long long v[8], vm = 0xbf800000ull; unsigned spin = 0;
#pragma unroll
    for (int i = 0; i < 8; ++i) v[i] = (8 * lq + i < n) ? __hip_atomic_load(lsum + ((size_t)b * NCHK + 8 * lq + i) * 1024 + ch, __ATOMIC_RELAXED, __HIP_MEMORY_SCOPE_AGENT) : 0xbf800000ull;
    if (lq == 0) vm = __hip_atomic_load(mslot + ch, __ATOMIC_RELAXED, __HIP_MEMORY_SCOPE_AGENT);
    for (;;) {
        bool ok = ((unsigned)vm >> 31) != 0u;
#pragma unroll
        for (int i = 0; i < 8; ++i) ok = ok && (((unsigned)v[i] >> 31) != 0u);
        if (__builtin_amdgcn_ballot_w64(!ok) == 0ull || ++spin > (1u << 18)) break;
        __builtin_amdgcn_s_sleep(8);
#pragma unroll
        for (int i = 0; i < 8; ++i) if (!((unsigned)v[i] >> 31)) v[i] = __hip_atomic_load(lsum + ((size_t)b * NCHK + 8 * lq + i) * 1024 + ch, __ATOMIC_RELAXED, __HIP_MEMORY_SCOPE_AGENT);
        if (!((unsigned)vm >> 31)) vm = __hip_atomic_load(mslot + ch, __ATOMIC_RELAXED, __HIP_MEMORY_SCOPE_AGENT);
    }
    float Pp = 1.f, Hp = 0.f;
#pragma unroll
    for (int i = 0; i < 8; ++i) { const float p = __uint_as_float((unsigned)v[i] & 0x7fffffffu), h = __uint_as_float((unsigned)(v[i] >> 32)); Hp = h + p * Hp; Pp *= p; }
    float cin = __shfl(__uint_as_float((unsigned)(vm >> 32)), li);
#pragma unroll
    for (int k = 0; k < 4; ++k) { const float pk = __shfl(Pp, li + 16 * k), hk = __shfl(Hp, li + 16 * k); cin = hk + pk * cin; }
#pragma unroll
    for (int m = 0; m < 8; ++m)
#pragma unroll
        for (int rg = 0; rg < 4; ++rg) XF[(16 * m + 4 * lq + rg) * 132 + cl] = ar[m][rg] + ai[m][rg] * cin;
    __syncthreads();
#pragma unroll
    for (int it = 0; it < 4; ++it) { const int t = tb + 32 * it; const f32x4 h0 = *(const LAS f32x4*)(XF + t * 132 + cg * 8), h1 = *(const LAS f32x4*)(XF + t * 132 + cg * 8 + 4); const u32x4 g = lgraw[it];
        u32x4 o; o.x = pk2(h0[0] * __uint_as_float(g[0] << 16), h0[1] * __uint_as_float(g[0] & 0xffff0000u)); o.y = pk2(h0[2] * __uint_as_float(g[1] << 16), h0[3] * __uint_as_float(g[1] & 0xffff0000u));
        o.z = pk2(h1[0] * __uint_as_float(g[2] << 16), h1[1] * __uint_as_float(g[2] & 0xffff0000u)); o.w = pk2(h1[2] * __uint_as_float(g[3] << 16), h1[3] * __uint_as_float(g[3] & 0xffff0000u));
        *(u32x4*)(WSP(bf16, WS_Y) + (row0 + t) * MIXW + ch0) = o; }
}
DI void meta_lru_item(const Ptrs& P, LAS unsigned char* lds, int item, int tid) {
    const int hh = item >> 4, cs = item & 15;
    LAS float* xcs = (LAS float*)lds;
    LAS float* prt = (LAS float*)(lds + 8192);
    LAS float* aus = (LAS float*)(lds + 12288);
    const float* mp = WSP(float, WS_METAP);
    const int c = tid & 7, j = (tid >> 3) & 15, kh = tid >> 7, co = cs * 8 + c, ch = hh * 128 + co;
    float wr[32], wi[32];
#pragma unroll
    for (int i = 0; i < 32; ++i) { wr[i] = P.w_rg[(hh * 128 + 32 * kh + i) * 128 + co]; wi[i] = P.w_ig[(hh * 128 + 32 * kh + i) * 128 + co]; }
    __syncthreads();
    { const int cc = tid & 127, jg = tid >> 7, chn = hh * 128 + cc;
      for (int jj = 0; jj < 4; ++jj) { const int jt = 4 * jg + jj; float s = P.conv_b[chn];
#pragma unroll
        for (int k = 0; k < 4; ++k) { const int js = jt - 3 + k; if (js >= 0) s += P.conv_w[k * 1024 + chn] * mp[js * MPW + chn]; }
        xcs[jt * 128 + cc] = s; } }
    __syncthreads();
    float rp = 0.f, ip = 0.f;
#pragma unroll
    for (int i = 0; i < 32; ++i) { const float xv = xcs[j * 128 + 32 * kh + i]; rp += xv * wr[i]; ip += xv * wi[i]; }
    prt[((kh * 16 + j) * 8 + c) * 2] = rp; prt[((kh * 16 + j) * 8 + c) * 2 + 1] = ip;
    __syncthreads();
    if (tid < 128) { float rz = P.b_rg[ch], iz = P.b_ig[ch];
#pragma unroll
        for (int q = 0; q < 4; ++q) { rz += prt[((q * 16 + j) * 8 + c) * 2]; iz += prt[((q * 16 + j) * 8 + c) * 2 + 1]; }
        const float r = fsig(rz), ig = fsig(iz), la = -8.0f * r * WSP(float, WS_SP)[ch], av = __expf(la);
        aus[(j * 8 + c) * 2] = av; aus[(j * 8 + c) * 2 + 1] = beta_from(la, av) * ig * xcs[j * 128 + co]; }
    __syncthreads();
    if (tid < 8) { float h = 0.f; for (int jj = 0; jj < 16; ++jj) h = aus[(jj * 8 + tid) * 2] * h + aus[(jj * 8 + tid) * 2 + 1];
        __hip_atomic_store(WSP(unsigned long long, WS_MSLOT) + hh * 128 + cs * 8 + tid, ((unsigned long long)__float_as_uint(h) << 32) | 0xbf800000ull, __ATOMIC_RELAXED, __HIP_MEMORY_SCOPE_AGENT); }
}
DI void meta_kv_item(const Ptrs& P, LAS unsigned char* lds, int item, int tid) {
    const int h = item >> 3, ds = item & 7;
    LAS float* ks = (LAS float*)lds;
    LAS float* vs = (LAS float*)(lds + 4096);
    const float* mp = WSP(float, WS_METAP); const float lg = loggh(h);
    __syncthreads();
    { const int j = tid >> 5, i = tid & 31; const float x1 = mp[j * MPW + 1024 + h * 64 + i], x2 = mp[j * MPW + 1024 + h * 64 + 32 + i]; const f32x2 cs = WSP(f32x2, WS_ROT)[j * 32 + i];
      const float dec = __expf((float)(15 - j) * lg) * 0.125f; ks[j * 64 + 2 * i] = (x1 * cs.x - x2 * cs.y) * dec; ks[j * 64 + 2 * i + 1] = (x1 * cs.y + x2 * cs.x) * dec; }
    for (int idx = tid; idx < 16 * 128; idx += NT) vs[idx] = mp[(idx >> 7) * MPW + 1536 + h * 128 + (idx & 127)];
    __syncthreads();
    for (int o = tid; o < 8 * 128; o += NT) { const int d = ds * 8 + (o >> 7), e = o & 127; float s = 0.f;
#pragma unroll
        for (int j = 0; j < 16; ++j) s += ks[j * 64 + d] * vs[j * 128 + e];
        WSP(float, WS_KVM)[h * 8192 + d * 128 + e] = s; }
}
template <int NPIECE_LOG2, int NPER>
struct Stage { u32x4 v[NPER];
    DI void load(const bf16* src, size_t sstride, int tid) {
#pragma unroll
        for (int i = 0; i < NPER; ++i) { const int p = tid + NT * i, r = p >> NPIECE_LOG2, c = p & ((1 << NPIECE_LOG2) - 1); v[i] = __builtin_nontemporal_load((const u32x4*)(src + (size_t)r * sstride + c * 8)); } }
    DI void store(LAS unsigned char* dst, int dstride, int tid) const {
#pragma unroll
        for (int i = 0; i < NPER; ++i) { const int p = tid + NT * i, r = p >> NPIECE_LOG2, c = p & ((1 << NPIECE_LOG2) - 1); *(LAS u32x4*)(dst + r * dstride + c * 16) = v[i]; } }
};
DI void tile_map(int j, int& b, int& n, int& h) { const int l = (j & 255) >> 3; n = 8 * (j >> 8) + (j & 7); b = l >> 3; h = l & 7; }
struct KvRegs { Stage<3, 2> sk; Stage<4, 4> sv; };
DI void kv_load(const Ptrs& P, int j, KvRegs& R, int tid) {
    int b, n, h; tile_map(j, b, n, h); const size_t row0 = (size_t)b * SEQ + (size_t)n * CHK;
    R.sk.load(WSP(bf16, WS_KK) + row0 * 512 + h * 64, 512, tid); R.sv.load(WSP(bf16, WS_V) + row0 * 1024 + h * 128, 1024, tid);
}
DI void kv_tile(const Ptrs& P, LAS unsigned char* lds, int j, int jnext, KvRegs& R, int tid) {
    int b, n, h; tile_map(j, b, n, h);
    LAS unsigned char* KD = lds;
    LAS unsigned char* VV = lds + 18432;
    const int wave = __builtin_amdgcn_readfirstlane(tid >> 6), lane = tid & 63, li = lane & 15, lg4 = lane >> 4, q4 = li >> 2, p4 = li & 3;
    const size_t row0 = (size_t)b * SEQ + (size_t)n * CHK; const float lg = loggh(h);
    __syncthreads();
#pragma unroll
    for (int it = 0; it < 2; ++it) { const int p = tid + NT * it, c = p >> 3, c8 = p & 7;
        const u32x4 w = R.sk.v[it]; const float dec = __expf((float)(127 - c) * lg); u32x4 o;
#pragma unroll
        for (int j = 0; j < 4; ++j) o[j] = pk2(__uint_as_float(w[j] << 16) * dec, __uint_as_float(w[j] & 0xffff0000u) * dec);
        *(LAS u32x4*)(KD + c * 144 + c8 * 16) = o; }
    R.sv.store(VV, 272, tid);
    __syncthreads();
    if (jnext >= 0) kv_load(P, jnext, R, tid);
    f32x4 acc[4];
#pragma unroll
    for (int db = 0; db < 4; ++db) acc[db] = (f32x4){0.f, 0.f, 0.f, 0.f};
#pragma unroll
    for (int cs = 0; cs < 4; ++cs) {
        const LAS unsigned char* vb = VV + (32 * cs + 8 * lg4 + q4) * 272 + (16 * wave + 4 * p4) * 2;
        const bf16x8 bf = cat8(tr_read(vb), tr_read(vb + 4 * 272));
#pragma unroll
        for (int db = 0; db < 4; ++db) { const LAS unsigned char* kb = KD + (32 * cs + 8 * lg4 + q4) * 144 + (16 * db + 4 * p4) * 2;
            const bf16x8 af = cat8(tr_read(kb), tr_read(kb + 4 * 144)); acc[db] = MFMA16(af, bf, acc[db]); }
    }
    float* o = P.out + (((size_t)b * NCHK + n) * 8 + h) * 8192;
#pragma unroll
    for (int db = 0; db < 4; ++db)
#pragma unroll
        for (int rg = 0; rg < 4; ++rg) o[(16 * db + 4 * lg4 + rg) * 128 + 16 * wave + li] = acc[db][rg];
}
DI void p3_scans(const Ptrs& P, int flags, int tid) {
    const int gt = blockIdx.x * NT + tid, GT = gridDim.x * NT;
    if (flags & 2) for (int idx = gt; idx < BATCH * 8 * 4096; idx += GT) {
        const int bh = idx >> 12, de = (idx & 4095) * 2, b = bh >> 3, h = bh & 7; const float G = __expf(128.0f * loggh(h));
        f32x2 st = *(const f32x2*)(WSP(float, WS_KVM) + h * 8192 + de); f32x2 kv[NCHK];
#pragma unroll
        for (int n = 0; n < NCHK; ++n) kv[n] = __builtin_nontemporal_load((const f32x2*)(P.out + (((size_t)b * NCHK + n) * 8 + h) * 8192 + de));
#pragma unroll
        for (int n = 0; n < NCHK; ++n) { *(unsigned*)(WSP(bf16, WS_RPREV) + (((size_t)b * NCHK + n) * 8 + h) * 8192 + de) = pk2(st.x, st.y); st = st * G + kv[n]; } }
}
struct RetRegs { Stage<3, 2> sq, sk; Stage<4, 4> sv; Stage<4, 2> sr; u32x4 rg[4]; };
DI void ret_load(const Ptrs& P, int j, RetRegs& R, int tid) {
    int b, n, h; tile_map(j, b, n, h); const size_t row0 = (size_t)b * SEQ + (size_t)n * CHK; const int tb = tid >> 4, cg = tid & 15;
    R.sq.load(WSP(bf16, WS_Q) + row0 * 512 + h * 64, 512, tid); R.sk.load(WSP(bf16, WS_KK) + row0 * 512 + h * 64, 512, tid);
    R.sv.load(WSP(bf16, WS_V) + row0 * 1024 + h * 128, 1024, tid); R.sr.load(WSP(bf16, WS_RPREV) + (((size_t)b * NCHK + n) * 8 + h) * 8192, 128, tid);
#pragma unroll
    for (int it = 0; it < 4; ++it) R.rg[it] = __builtin_nontemporal_load((const u32x4*)(WSP(bf16, WS_RG) + (row0 + tb + 32 * it) * 1024 + h * 128 + cg * 8));
}
DI void ret_tile(const Ptrs& P, LAS unsigned char* lds, int j, int jnext, RetRegs& R, int tid) {
    int b, n, h; tile_map(j, b, n, h);
    LAS unsigned char* QS = lds;
    LAS unsigned char* KS = lds + 18432;
    LAS unsigned char* VS = lds + 36864;
    LAS unsigned char* RS = lds + 71680;
    LAS unsigned char* SS = lds + 89088;
    const int wave = __builtin_amdgcn_readfirstlane(tid >> 6), lane = tid & 63, li = lane & 15, lg4 = lane >> 4, q4 = li >> 2, p4 = li & 3;
    const size_t row0 = (size_t)b * SEQ + (size_t)n * CHK; const float lg = loggh(h);
    float gnv[8]; u32x4 rgraw[4]; const int tb = tid >> 4, cg = tid & 15;
#pragma unroll
    for (int eb = 0; eb < 8; ++eb) gnv[eb] = P.rng[h * 128 + 16 * eb + li];
    __syncthreads();
    R.sq.store(QS, 144, tid); R.sk.store(KS, 144, tid); R.sv.store(VS, 272, tid); R.sr.store(RS, 272, tid);
#pragma unroll
    for (int it = 0; it < 4; ++it) rgraw[it] = R.rg[it];
    __syncthreads();
    if (jnext >= 0) ret_load(P, jnext, R, tid);
    bf16x8 aq[2];
#pragma unroll
    for (int ks = 0; ks < 2; ++ks) aq[ks] = *(const LAS bf16x8*)(QS + (16 * wave + li) * 144 + (32 * ks + 8 * lg4) * 2);
    const int mbmax = wave | 1;
    for (int mb = 0; mb <= mbmax; mb += 2) {
        bf16x8 bk[2][2];
#pragma unroll
        for (int u = 0; u < 2; ++u)
#pragma unroll
            for (int ks = 0; ks < 2; ++ks) bk[u][ks] = *(const LAS bf16x8*)(KS + (16 * (mb + u) + li) * 144 + (32 * ks + 8 * lg4) * 2);
        f32x4 s2[2];
#pragma unroll
        for (int u = 0; u < 2; ++u) { s2[u] = (f32x4){0.f, 0.f, 0.f, 0.f}; s2[u] = MFMA16(aq[0], bk[u][0], s2[u]); }
#pragma unroll
        for (int u = 0; u < 2; ++u) s2[u] = MFMA16(aq[1], bk[u][1], s2[u]);
#pragma unroll
        for (int u = 0; u < 2; ++u)
#pragma unroll
            for (int rg = 0; rg < 4; ++rg) { const int c = 16 * wave + 4 * lg4 + rg, m = 16 * (mb + u) + li, dd = c - m; const float e = __expf((float)(dd > 0 ? dd : 0) * lg);
                const float w = dd >= 0 ? s2[u][rg] * e : 0.f; *(LAS bf16*)(SS + c * 272 + m * 2) = f2bf(w); }
    }
    __syncthreads();
    f32x4 oin[8], ox[8];
#pragma unroll
    for (int eb = 0; eb < 8; ++eb) { oin[eb] = (f32x4){0.f, 0.f, 0.f, 0.f}; ox[eb] = (f32x4){0.f, 0.f, 0.f, 0.f}; }
    const int msmax = wave >> 1;
    for (int ms = 0; ms <= msmax; ++ms) {
        const bf16x8 as = *(const LAS bf16x8*)(SS + (16 * wave + li) * 272 + (32 * ms + 8 * lg4) * 2);
        s16x4 tv[8][2];
#pragma unroll
        for (int eb = 0; eb < 8; ++eb) { const LAS unsigned char* vb = VS + (32 * ms + 8 * lg4 + q4) * 272 + (16 * eb + 4 * p4) * 2; tv[eb][0] = tr_read(vb); tv[eb][1] = tr_read(vb + 4 * 272); }
#pragma unroll
        for (int eb = 0; eb < 8; ++eb) oin[eb] = MFMA16(as, cat8(tv[eb][0], tv[eb][1]), oin[eb]);
    }
#pragma unroll
    for (int ks = 0; ks < 2; ++ks)
#pragma unroll
        for (int eb = 0; eb < 8; ++eb) { const LAS unsigned char* rb = RS + (32 * ks + 8 * lg4 + q4) * 272 + (16 * eb + 4 * p4) * 2;
            ox[eb] = MFMA16(aq[ks], cat8(tr_read(rb), tr_read(rb + 4 * 272)), ox[eb]); }
    __syncthreads();
    LAS float* OF = (LAS float*)lds;
#pragma unroll
    for (int rg = 0; rg < 4; ++rg) {
        const int c = 16 * wave + 4 * lg4 + rg; const float dq = __expf((float)(c + 1) * lg); float o[8], s = 0.f;
#pragma unroll
        for (int eb = 0; eb < 8; ++eb) { o[eb] = oin[eb][rg] + dq * ox[eb][rg]; s += o[eb]; }
        s += __shfl_xor(s, 1); s += __shfl_xor(s, 2); s += __shfl_xor(s, 4); s += __shfl_xor(s, 8);
        const float mu = s * (1.0f / 128.0f); float q = 0.f;
#pragma unroll
        for (int eb = 0; eb < 8; ++eb) { o[eb] -= mu; q += o[eb] * o[eb]; }
        q += __shfl_xor(q, 1); q += __shfl_xor(q, 2); q += __shfl_xor(q, 4); q += __shfl_xor(q, 8);
        const float rs = 1.0f / sqrtf(q * (1.0f / 128.0f) + EPSN);
#pragma unroll
        for (int eb = 0; eb < 8; ++eb) OF[c * 132 + 16 * eb + li] = o[eb] * rs * gnv[eb];
    }
    __syncthreads();
#pragma unroll
    for (int it = 0; it < 4; ++it) { const int t = tb + 32 * it; const f32x4 h0 = *(const LAS f32x4*)(OF + t * 132 + cg * 8), h1 = *(const LAS f32x4*)(OF + t * 132 + cg * 8 + 4); const u32x4 g = rgraw[it];
        u32x4 o; o.x = pk2(h0[0] * __uint_as_float(g[0] << 16), h0[1] * __uint_as_float(g[0] & 0xffff0000u)); o.y = pk2(h0[2] * __uint_as_float(g[1] << 16), h0[3] * __uint_as_float(g[1] & 0xffff0000u));
        o.z = pk2(h1[0] * __uint_as_float(g[2] << 16), h1[1] * __uint_as_float(g[2] & 0xffff0000u)); o.w = pk2(h1[2] * __uint_as_float(g[3] << 16), h1[3] * __uint_as_float(g[3] & 0xffff0000u));
        *(u32x4*)(WSP(bf16, WS_Y) + (row0 + t) * MIXW + 1024 + h * 128 + cg * 8) = o; }
}
#define XB_TMO      128
#define XB_XCNT(j)  (256  + 64 * (j))
#define XB_XSUB(j)  (1280 + 64 * (j))
#define XB_XGEN(j)  (2304 + 64 * (j))
#define XB_TOP      3328
#define XB_TOPGEN   3392
#define XCD_BAR_WORDS 3456
#define XB_SPIN_CAP (1u << 18)

__device__ __forceinline__ unsigned xb_ld(unsigned* p)              { return __hip_atomic_load(p, __ATOMIC_RELAXED, __HIP_MEMORY_SCOPE_AGENT); }
__device__ __forceinline__ unsigned xb_add(unsigned* p, unsigned v) { return __hip_atomic_fetch_add(p, v, __ATOMIC_RELAXED, __HIP_MEMORY_SCOPE_AGENT); }
__device__ __forceinline__ unsigned xb_xcc_id() { return (unsigned)__builtin_amdgcn_s_getreg((3 << 11) | 20) & 0xFu; }
#define XB_SPIN(cond, bar) do { unsigned _sp = 0; while (cond) { __builtin_amdgcn_s_sleep(6); \
    if ((++_sp & 255u) == 0u) { if (xb_ld(&(bar)[XB_TMO])) break; if (_sp > XB_SPIN_CAP) { atomicAdd(&(bar)[XB_TMO], 1u); break; } } } } while (0)

struct XcdBarrier {
    unsigned* bar; unsigned x;
    volatile LAS unsigned* st;
};

__device__ __forceinline__ XcdBarrier xcd_barrier_post(unsigned* bar, volatile LAS unsigned* st) {
    XcdBarrier b; b.bar = bar; b.x = xb_xcc_id(); b.st = st;
    if (threadIdx.x == 0) (void)xb_add(&bar[XB_XCNT(b.x)], 1u);
    return b;
}
__device__ __forceinline__ void xcd_barrier_complete(unsigned* bar, unsigned x, unsigned& nloc, unsigned& nx) {
    const unsigned G = gridDim.x * gridDim.y * gridDim.z;
    unsigned sum, cnt, mine, sp = 0u;
    for (;;) {
        sum = 0u; cnt = 0u; mine = 0u;
#pragma unroll
        for (unsigned j = 0; j < 16; ++j) { const unsigned c = xb_ld(&bar[XB_XCNT(j)]); sum += c; cnt += (c > 0u) ? 1u : 0u; mine = (j == x) ? c : mine; }
        if (sum == G) break;
        __builtin_amdgcn_s_sleep(1);
        if ((++sp & 255u) == 0u) { if (xb_ld(&bar[XB_TMO])) break; if (sp > XB_SPIN_CAP) { atomicAdd(&bar[XB_TMO], 1u); break; } }
    }
    nloc = mine > 0u ? mine : 1u; nx = cnt > 0u ? cnt : 1u;
}

__device__ __forceinline__ void xcd_barrier(const XcdBarrier& b) {
    asm volatile("s_waitcnt vmcnt(0)" ::: "memory");
    __syncthreads();
    if (threadIdx.x == 0) {
        unsigned* bar = b.bar;
        __builtin_amdgcn_s_waitcnt(0);
        unsigned nloc = b.st[0], nx = b.st[1];
        if (nloc == 0u) { xcd_barrier_complete(bar, b.x, nloc, nx); b.st[0] = nloc; b.st[1] = nx; }
        const unsigned old = xb_add(&bar[XB_XSUB(b.x)], 1u);
        const unsigned gen = old / nloc;
        if (old + 1u == (gen + 1u) * nloc) {
            __builtin_amdgcn_fence(__ATOMIC_RELEASE, "agent");
            asm volatile("s_waitcnt vmcnt(0)" ::: "memory");
            const unsigned og = xb_add(&bar[XB_TOP], 1u);
            const unsigned tg = og / nx;
            if (og + 1u == (tg + 1u) * nx) xb_add(&bar[XB_TOPGEN], 1u);
            else XB_SPIN(xb_ld(&bar[XB_TOPGEN]) == tg, bar);
            __builtin_amdgcn_fence(__ATOMIC_ACQUIRE, "agent");
            xb_add(&bar[XB_XGEN(b.x)], 1u);
            asm volatile("s_waitcnt vmcnt(0)" ::: "memory");
        } else {
            XB_SPIN(xb_ld(&bar[XB_XGEN(b.x)]) == gen, bar);
            __builtin_amdgcn_fence(__ATOMIC_ACQUIRE, "agent");
            asm volatile("s_waitcnt vmcnt(0)" ::: "memory");
        }
    }
    __syncthreads();
}
#ifdef NO_LRU
#define lru_tile(...) ((void)0)
#endif
#ifdef NO_RET
#define ret_tile(...) ((void)0)
#endif
#ifdef NO_KV
#define kv_tile(...) ((void)0)
#endif
#ifdef NO_P3
#define p3_scans(...) ((void)0)
#endif
#ifdef NO_P0
#define p0_prologue(...) ((void)0)
#endif
#ifndef OPT_P0
#define OPT_P0 1
#endif
#ifndef OPT_P1
#define OPT_P1 1
#endif
#ifndef OPT_LRU
#define OPT_LRU 1
#endif
#ifndef OPT_RET
#define OPT_RET 1
#endif
#ifndef OPT_P5
#define OPT_P5 1
#endif
#ifndef FUSED
#define FUSED 1
#endif
#ifndef PROBE_FLAGS
#define PROBE_FLAGS 3
#endif
#ifndef PROBE_P0
#define PROBE_P0 0
#endif
#ifndef PROBE_P1
#define PROBE_P1 0
#endif
#ifndef PROBE_P24
#define PROBE_P24 0
#endif
#ifndef PROBE_P3
#define PROBE_P3 0
#endif
#ifndef PROBE_P5
#define PROBE_P5 0
#endif
struct Args { Ptrs P; int ph_lo, ph_hi, flags, pad; };
__global__ void __launch_bounds__(NT, 2) mega(Args a) {
    extern __shared__ __attribute__((aligned(16))) unsigned char lds_raw[];
    cg::grid_group grid = cg::this_grid();
    LAS unsigned char* lds = (LAS unsigned char*)lds_raw;
    const Ptrs& P = a.P; const int tid = threadIdx.x, G = gridDim.x, lo = a.ph_lo, hi = a.ph_hi, flags = a.flags;
    volatile LAS unsigned* bst = (volatile LAS unsigned*)(lds + 131072 + 256);
    if (tid < 2) bst[tid] = 0u;
    __syncthreads();
    const XcdBarrier bar = xcd_barrier_post(WSP(unsigned, WS_BAR), bst);
    if (a.pad == 0x7fffffff) grid.sync();
#define IN(k) (lo <= (k) && (k) < hi)
#define SEAM(k) do { if (IN(k) && IN((k) + 1)) xcd_barrier(bar); } while (0)
#ifdef PROBE_SYNC
    for (int i = 0; i < 10; ++i) xcd_barrier(bar);
#endif
    if (IN(0)) { p0_prologue(P, lds, tid); if (PROBE_P0) { xcd_barrier(bar); p0_prologue(P, lds, tid); } }
    SEAM(0);
    if (IN(1)) {
        pg8::Gemm g{WSP(bf16, WS_HB), WSP(bf16, WS_W1T), MROWS, INW, DM}; pg8::StaticOrder S; S.init(MROWS, INW, G, (int)blockIdx.x);
        pg8::Epi1 E{WSP(float, WS_RSTD), (const pg8::f32x2e*)WSP(f32x2, WS_ROT), WSP(bf16, WS_LX), WSP(bf16, WS_LG), WSP(bf16, WS_Q), WSP(bf16, WS_KK), WSP(bf16, WS_V), WSP(bf16, WS_RG)};
        pg8::gemm_phase<pg8::Epi1, pg8::StaticOrder, true, true>(lds, g, S, E);
        if (PROBE_P1) { xcd_barrier(bar); pg8::gemm_phase<pg8::Epi1, pg8::StaticOrder, true, true>(lds, g, S, E); }
    }
    SEAM(1);
    if (IN(2)) {
        for (int rep = 0; rep < (PROBE_P24 ? 2 : 1); ++rep) { const int flags = rep ? PROBE_P24 : a.flags; if (rep) xcd_barrier(bar);
        if ((flags & 1) && (int)blockIdx.x < 128) meta_lru_item(P, lds, blockIdx.x, tid);
        if (flags & 1) { LruConst LC; LC.hh = -1;
            for (int it = blockIdx.x; it < 1024; it += G) { int b, n, hh; tile_map(it, b, n, hh); lru_tile(P, lds, b, n, hh, tid, LC); } }
        if (flags & 2) { if ((int)blockIdx.x >= 128 && (int)blockIdx.x < 192) meta_kv_item(P, lds, blockIdx.x - 128, tid);
            KvRegs KR; int it = blockIdx.x; if (it < 1024) kv_load(P, it, KR, tid);
            for (; it < 1024; it += G) kv_tile(P, lds, it, it + G < 1024 ? it + G : -1, KR, tid); }
        }
    }
    SEAM(2);
    if (IN(3)) { p3_scans(P, flags, tid); if (PROBE_P3) { xcd_barrier(bar); p3_scans(P, flags, tid); } }
    SEAM(3);
    if (IN(4)) {
        for (int rep = 0; rep < (PROBE_P24 ? 2 : 1); ++rep) { const int flags = rep ? PROBE_P24 : a.flags; if (rep) xcd_barrier(bar);
        if (flags & 2) { RetRegs RR; if ((int)blockIdx.x < 1024) ret_load(P, blockIdx.x, RR, tid);
            for (int it = blockIdx.x; it < 1024; it += G) ret_tile(P, lds, it, it + G < 1024 ? it + G : -1, RR, tid); } }
    }
    SEAM(4);
    if (IN(5)) {
        __syncthreads();
        pg8::Gemm g{WSP(bf16, WS_Y), WSP(bf16, WS_W2T), MROWS, DM, MIXW}; pg8::StaticOrder S; S.init(MROWS, DM, G, (int)blockIdx.x);
        if (G == 256) { pg8::Epi5F E{P.x, P.out, P.fgain, WSP(unsigned, WS_XBUF), WSP(unsigned, WS_PCNT)};
            pg8::gemm_phase<pg8::Epi5F, pg8::StaticOrder, false, true>(lds, g, S, E); }
        else { pg8::Epi5 E{P.x, P.out}; pg8::gemm_phase<pg8::Epi5, pg8::StaticOrder, false, true>(lds, g, S, E); }
    }
    if (G != 256) {
    SEAM(5);
    if (IN(6)) { const int gw = blockIdx.x * 8 + (tid >> 6), NGW = G * 8; for (int m = gw; m < MROWS; m += NGW) final_norm_row(P.out + (size_t)m * DM, P.fgain, tid & 63); }
    }
#undef IN
#undef SEAM
}

static int g_grid = 0;
static void launch_mega(const Ptrs& P, int lo, int hi, int flags, hipStream_t stream) {
    Args a{}; a.P = P; a.ph_lo = lo; a.ph_hi = hi; a.flags = flags; a.pad = 0;
    void* args[] = {&a};
    (void)hipMemsetAsync(P.ws + WS_BAR, 0, WS_ZERO_BYTES, stream);
    hipError_t e = hipLaunchCooperativeKernel((const void*)mega, dim3(g_grid), dim3(NT), args, LDS_BYTES, stream);
    if (e != hipSuccess) fprintf(stderr, "cooperative launch failed: %s (grid %d)\n", hipGetErrorString(e), g_grid);
}
extern "C" void kernel_launch(void* const* d_in, const int* in_sizes, int n_in, void* d_out, int out_size, void* d_ws, size_t ws_size, hipStream_t stream) {
    if (g_grid == 0) {
        int dev = 0, cus = 0, per_cu = 0;
        hipGetDevice(&dev); hipDeviceGetAttribute(&cus, hipDeviceAttributeMultiprocessorCount, dev);
        hipFuncSetAttribute((const void*)mega, hipFuncAttributeMaxDynamicSharedMemorySize, LDS_BYTES);
        hipFuncSetAttribute((const void*)n_lru, hipFuncAttributeMaxDynamicSharedMemorySize, (2 * 128 * 128 + 128) * 4);
        hipOccupancyMaxActiveBlocksPerMultiprocessor(&per_cu, (const void*)mega, NT, LDS_BYTES);
        if (per_cu < 1) { fprintf(stderr, "occupancy query: %d blocks per CU\n", per_cu); per_cu = 1; }
        g_grid = cus * 1;
        if (n_in != 14 || ws_size < WS_END) fprintf(stderr, "unexpected n_in %d / ws_size %zu\n", n_in, ws_size);
    }
    Ptrs P{};
    P.x = (const float*)d_in[0]; P.meta = (const float*)d_in[1]; P.ngain = (const float*)d_in[2]; P.w_in = (const float*)d_in[3]; P.conv_w = (const float*)d_in[4]; P.conv_b = (const float*)d_in[5];
    P.w_rg = (const float*)d_in[6]; P.b_rg = (const float*)d_in[7]; P.w_ig = (const float*)d_in[8]; P.b_ig = (const float*)d_in[9]; P.lam = (const float*)d_in[10]; P.rng = (const float*)d_in[11];
    P.w_out = (const float*)d_in[12]; P.fgain = (const float*)d_in[13]; P.out = (float*)d_out; P.ws = (unsigned char*)d_ws;
#if FUSED
#ifdef PROBE_PREFIX
    launch_mega(P, 0, PROBE_PREFIX, PROBE_FLAGS, stream);
#endif
    launch_mega(P, 0, 7, 3, stream);
#ifdef PROBE_TWICE
    launch_mega(P, 0, 7, 3, stream);
#endif
#else
    if (OPT_P0) launch_mega(P, 0, 1, 3, stream);
    else { n0_rows<<<MROWS * 64 / 256, 256, 0, stream>>>(P); n0_misc<<<(TPOS * 32 + 1024 + 255) / 256, 256, 0, stream>>>(P); n0_w1t<<<INW * DM / 256, 256, 0, stream>>>(P);
           n0_w2t<<<DM * MIXW / 256, 256, 0, stream>>>(P); n0_wgt<<<2 * 8 * 128 * 128 / 256, 256, 0, stream>>>(P); n0_meta<<<NMETA * MPW / 256, 256, 0, stream>>>(P); }
    if (OPT_P1) launch_mega(P, 1, 2, 3, stream);
    else n1_gemm1<<<(unsigned)((size_t)MROWS * (INW / 2) / 256), 256, 0, stream>>>(P);
    if (OPT_LRU || OPT_RET) launch_mega(P, 2, 5, (OPT_LRU ? 1 : 0) | (OPT_RET ? 2 : 0), stream);
    if (!OPT_LRU) n_lru<<<BATCH * 8, 128, (2 * 128 * 128 + 128) * 4, stream>>>(P);
    if (!OPT_RET) n_ret<<<BATCH * 8, 128, 0, stream>>>(P);
    if (OPT_P5) launch_mega(P, 5, 7, 3, stream);
    else { n5_gemm2<<<MROWS * (DM / 2) / 256, 256, 0, stream>>>(P); n6_norm<<<MROWS * 64 / 256, 256, 0, stream>>>(P); }
#endif
}
```
